# Optimizing an MI355X kernel written in HIP

```python
import jax, jax.numpy as jnp
from jax import lax
import numpy as np

D_MODEL = 1024
BATCH = 2
SEQ = 8192
DEPTH = 1

D_MIX = D_MODEL
D_POOL = D_MIX // 2
D_LRU = D_MIX - D_POOL
POOL_WINDOWS = (2, 4, 8, 16)
N_POOL_GROUPS = len(POOL_WINDOWS)
POOL_GROUP_WIDTH = D_POOL // N_POOL_GROUPS
LRU_HEADS = 8
LRU_BLOCK = D_LRU // LRU_HEADS
CONV_WIDTH = 4
LRU_C = 8.0
D_FF = 4 * D_MODEL
PLE_DIM = 256
RMS_EPS = 1e-6
D_IN_PROJ = D_POOL + D_LRU + D_LRU

kernel_name = "hybrid_pool_rglru_block"


def rms_norm(x, g):
    xf = x.astype(jnp.float32)
    y = xf * lax.rsqrt(jnp.mean(xf * xf, axis=-1, keepdims=True) + RMS_EPS)
    return (y * g.astype(jnp.float32)).astype(x.dtype)


def multiscale_pool_mixer(u, pool_w, pool_b, pool_scale):
    B, S, _ = u.shape
    ug = u.reshape(B, S, N_POOL_GROUPS, POOL_GROUP_WIDTH).astype(jnp.float32)
    csum = jnp.cumsum(ug, axis=1)
    t = jnp.arange(S)
    outs = []
    for g, w in enumerate(POOL_WINDOWS):
        c = csum[:, :, g]
        c_lag = jnp.pad(c, ((0, 0), (w, 0), (0, 0)))[:, :S]
        count = jnp.minimum(t + 1, w).astype(jnp.float32)
        outs.append((c - c_lag) / count[None, :, None] - ug[:, :, g])
    d = jnp.stack(outs, axis=2).astype(u.dtype)
    y = jnp.einsum('bsgc,gcd->bsgd', d, pool_w) + pool_b
    return y.reshape(B, S, D_POOL) * pool_scale


def causal_depthwise_conv(u, w, b):
    S = u.shape[1]
    upad = jnp.pad(u, ((0, 0), (CONV_WIDTH - 1, 0), (0, 0)))
    y = b
    for k in range(CONV_WIDTH):
        y = y + upad[:, k:k + S] * w[k]
    return y


def _linear_recurrence_combine(c1, c2):
    a1, b1 = c1
    a2, b2 = c2
    return a1 * a2, a2 * b1 + b2


def rg_lru(u, gate_a_w, gate_a_b, gate_x_w, gate_x_b, lru_L):
    B, S, W = u.shape
    uh = u.reshape(B, S, LRU_HEADS, LRU_BLOCK)
    r = jax.nn.sigmoid(jnp.einsum('bshi,hij->bshj', uh, gate_a_w) + gate_a_b).reshape(B, S, W)
    i = jax.nn.sigmoid(jnp.einsum('bshi,hij->bshj', uh, gate_x_w) + gate_x_b).reshape(B, S, W)
    log_a = LRU_C * r.astype(jnp.float32) * jax.nn.log_sigmoid(lru_L.astype(jnp.float32))
    a = jnp.exp(log_a)
    mult = jnp.sqrt(-jnp.expm1(2.0 * log_a))
    is_first = (jnp.arange(S) == 0)[None, :, None]
    mult = jnp.where(is_first, 1.0, mult)
    b = mult * (i * u).astype(jnp.float32)
    _, h = lax.associative_scan(_linear_recurrence_combine, (a, b), axis=1)
    return h.astype(u.dtype)


def setup_inputs(seed: int = 0) -> dict:
    key = jax.random.key(seed)
    ks = jax.random.split(key, 24)
    f32 = jnp.float32
    nrm = lambda k, shape, scale: jax.random.normal(k, shape, f32) * scale
    gain = lambda k, shape: 1.0 + 0.05 * jax.random.normal(k, shape, f32)
    L = DEPTH
    rad = jnp.sqrt(jax.random.uniform(ks[12], (L, D_LRU), f32, 0.9 ** 2, 0.999 ** 2))
    lru_L = jnp.log(rad) - jnp.log1p(-rad)
    return {
        "x": jax.random.normal(ks[0], (BATCH, SEQ, D_MODEL), f32),
        "p": jax.random.normal(ks[1], (DEPTH, BATCH, SEQ, PLE_DIM), f32),
        "norm_mix_g": gain(ks[2], (L, D_MODEL)),
        "w_in": nrm(ks[3], (L, D_MODEL, D_IN_PROJ), D_MODEL ** -0.5),
        "pool_w": nrm(ks[4], (L, N_POOL_GROUPS, POOL_GROUP_WIDTH, POOL_GROUP_WIDTH), POOL_GROUP_WIDTH ** -0.5),
        "pool_b": nrm(ks[5], (L, N_POOL_GROUPS, POOL_GROUP_WIDTH), 0.01),
        "pool_scale": gain(ks[6], (L, D_POOL)),
        "conv_w": nrm(ks[7], (L, CONV_WIDTH, D_LRU), CONV_WIDTH ** -0.5),
        "conv_b": nrm(ks[8], (L, D_LRU), 0.01),
        "gate_a_w": nrm(ks[9], (L, LRU_HEADS, LRU_BLOCK, LRU_BLOCK), LRU_BLOCK ** -0.5),
        "gate_a_b": nrm(ks[10], (L, LRU_HEADS, LRU_BLOCK), 0.01),
        "gate_x_w": nrm(ks[11], (L, LRU_HEADS, LRU_BLOCK, LRU_BLOCK), LRU_BLOCK ** -0.5),
        "gate_x_b": nrm(ks[13], (L, LRU_HEADS, LRU_BLOCK), 0.01),
        "lru_L": lru_L,
        "w_out": nrm(ks[14], (L, D_MIX, D_MODEL), D_MIX ** -0.5),
        "norm_mlp_g": gain(ks[15], (L, D_MODEL)),
        "w_up": nrm(ks[16], (L, D_MODEL, D_FF), D_MODEL ** -0.5),
        "w_down": nrm(ks[17], (L, D_FF, D_MODEL), D_FF ** -0.5),
        "norm_ple_g": gain(ks[18], (L, D_MODEL)),
        "w_ple_gate": nrm(ks[19], (L, D_MODEL, D_MODEL), D_MODEL ** -0.5),
        "b_ple_gate": nrm(ks[20], (L, D_MODEL), 0.01),
        "w_ple_proj": nrm(ks[21], (L, PLE_DIM, D_MODEL), PLE_DIM ** -0.5),
        "norm_final_g": gain(ks[22], (D_MODEL,)),
    }


def reference(x, p, norm_mix_g, w_in, pool_w, pool_b, pool_scale, conv_w, conv_b,
              gate_a_w, gate_a_b, gate_x_w, gate_x_b, lru_L, w_out, norm_mlp_g,
              w_up, w_down, norm_ple_g, w_ple_gate, b_ple_gate, w_ple_proj, norm_final_g):
    h = x
    for l in range(DEPTH):
        z = rms_norm(h, norm_mix_g[l])
        proj = z @ w_in[l]
        u_pool = proj[..., :D_POOL]
        u_lru = proj[..., D_POOL:D_POOL + D_LRU]
        u_gate = proj[..., D_POOL + D_LRU:]
        y_pool = multiscale_pool_mixer(u_pool, pool_w[l], pool_b[l], pool_scale[l])
        xb = causal_depthwise_conv(u_lru, conv_w[l], conv_b[l])
        y_lru = rg_lru(xb, gate_a_w[l], gate_a_b[l], gate_x_w[l], gate_x_b[l], lru_L[l])
        y_lru = y_lru * jax.nn.gelu(u_gate)
        h = h + jnp.concatenate([y_pool, y_lru], axis=-1) @ w_out[l]
        z = rms_norm(h, norm_mlp_g[l])
        h = h + jnp.square(jax.nn.relu(z @ w_up[l])) @ w_down[l]
        z = rms_norm(h, norm_ple_g[l])
        gate = jax.nn.sigmoid(z @ w_ple_gate[l] + b_ple_gate[l])
        h = h + gate * (p[l] @ w_ple_proj[l])
    return rms_norm(h, norm_final_g)
```

```cpp
#include <hip/hip_runtime.h>
#include <cstdio>
#include <cstdint>
namespace pg8 {
#define PG8_LAS __attribute__((address_space(3)))
typedef unsigned short bf16_t;
typedef short bf16x8 __attribute__((ext_vector_type(8)));
typedef float f32x4 __attribute__((ext_vector_type(4)));
typedef unsigned u32x4 __attribute__((ext_vector_type(4)));
constexpr int BM = 256, BK = 64, HALF = 128, HTB = HALF * BK * 2  , STAGE_BYTES = 8 * HTB, NXCD = 8, WGM = 8;

__host__ __device__ __forceinline__ int lds_byte(int r, int c) { const int st = (r >> 4) * 2 + (c >> 5), rr = r & 15, cc = c & 31, ob = rr * 64 + cc * 2; return st * 1024 + (ob ^ (((ob >> 9) & 1) << 5)); }
__host__ __device__ __forceinline__ void stage_rc(int b, int& R, int& C) { const int st = b / 1024, sb = b % 1024, swz = sb ^ (((sb >> 9) & 1) << 5); R = (st >> 1) * 16 + swz / 64; C = (st & 1) * 32 + (swz % 64) / 2; }
__host__ __device__ __forceinline__ int perm32(int rho) { const int n = rho >> 4, i = rho & 15; return 8 * (i >> 2) + 4 * n + (i & 3); }

struct Unit { int pm, pn; };
struct Gemm { const bf16_t* A; const bf16_t* Bt; int M, N, K; };

struct StaticOrder {
    int nM, nN, nwg, G, c;
    __host__ __device__ void init(int M, int N, int G_, int c_) { nM = M / BM; nN = N / BM; nwg = nM * nN; G = G_; c = c_; }
    __host__ __device__ bool next(int i, Unit& u) const {
        const long L = (long)i * G + c; if (L >= nwg) return false;
        int wgid = (int)L; { const int q = nwg / NXCD, r = nwg % NXCD, xcd = wgid % NXCD, off = wgid / NXCD; wgid = (xcd < r ? xcd * (q + 1) : r * (q + 1) + (xcd - r) * q) + off; }
        const int nig = WGM * nN, gid = wgid / nig, fm = gid * WGM, gsz = (nM - fm) < WGM ? (nM - fm) : WGM;
        u.pm = fm + ((wgid % nig) % gsz); u.pn = (wgid % nig) / gsz; return true;
    }
    __device__ __forceinline__ void a_ready(const Unit&) const {}
    __device__ __forceinline__ void done(const Unit&) const {}
};

__device__ __forceinline__ unsigned cvt_pk_bf16(float lo, float hi) { unsigned r; asm volatile("v_cvt_pk_bf16_f32 %0, %1, %2" : "=v"(r) : "v"(lo), "v"(hi)); return r; }
typedef float f32x2 __attribute__((ext_vector_type(2)));
__device__ __forceinline__ f32x2 gelu_pk(f32x2 v) {
    const f32x2 av = __builtin_elementwise_abs(v), d = av * 0.2316418882f + 1.0f;
    f32x2 t; t.x = __builtin_amdgcn_rcpf(d.x); t.y = __builtin_amdgcn_rcpf(d.y);
    f32x2 q = t * 0.5307027145f + (-0.7265760135f); q = q * t + 0.7107068705f; q = q * t + (-0.142248368f); q = q * t + 0.127414796f; q = q * t;
    const f32x2 s = (v * v) * (-0.72134752044f);
    f32x2 e; e.x = __builtin_amdgcn_exp2f(s.x); e.y = __builtin_amdgcn_exp2f(s.y);
    const f32x2 m = v * (q * e), r = v - m;
    f32x2 o; o.x = v.x < 0.f ? m.x : r.x; o.y = v.y < 0.f ? m.y : r.y; return o;
}

template <int ACT  > struct EpiBf16 {
    static constexpr bool PERM = true, AFTER_DRAIN = false; static_assert(ACT == 0 || ACT == 1, "EpiBf16: ACT is 0 (none) or 1 (gelu_pk)");
    bf16_t* O; int ldc; const float* bias; int split_cols; size_t split_stride; float scale0;
    __device__ __forceinline__ void operator()(const f32x4 (&acc)[2][2][4][2], const Unit& u, int wr, int wc, int fr, int fq) const {
        const int row0 = u.pm * BM + wr * 64 + fr; int colt = u.pn * BM; bf16_t* base = O;
        float sc = 1.f; if (split_cols) { const int t = colt / split_cols; base += (size_t)t * split_stride; colt -= t * split_cols; if (t == 0) sc = scale0; }
        const int col0 = colt + wc * 32 + 8 * fq, bcol0 = u.pn * BM + wc * 32 + 8 * fq;
        f32x4 bv[2][2];
#pragma unroll
        for (int bj = 0; bj < 2; ++bj)
#pragma unroll
            for (int n = 0; n < 2; ++n) bv[bj][n] = bias ? *(const f32x4*)(bias + bcol0 + bj * HALF + 4 * n) : (f32x4){0.f, 0.f, 0.f, 0.f};
#pragma unroll
        for (int ai = 0; ai < 2; ++ai)
#pragma unroll
            for (int m = 0; m < 4; ++m) { bf16_t* rowp = base + (size_t)(row0 + ai * HALF + m * 16) * ldc + col0;
#pragma unroll
                for (int bj = 0; bj < 2; ++bj) { f32x4 v0 = acc[ai][bj][m][0] + bv[bj][0], v1 = acc[ai][bj][m][1] + bv[bj][1];
                    if (ACT == 1) { f32x2 a = gelu_pk((f32x2){v0[0], v0[1]}), b = gelu_pk((f32x2){v0[2], v0[3]}), c = gelu_pk((f32x2){v1[0], v1[1]}), d = gelu_pk((f32x2){v1[2], v1[3]});
                        v0 = (f32x4){a.x, a.y, b.x, b.y}; v1 = (f32x4){c.x, c.y, d.x, d.y}; }
                    v0 = v0 * sc; v1 = v1 * sc; u32x4 w; w.x = cvt_pk_bf16(v0[0], v0[1]); w.y = cvt_pk_bf16(v0[2], v0[3]); w.z = cvt_pk_bf16(v1[0], v1[1]); w.w = cvt_pk_bf16(v1[2], v1[3]);
                    *(u32x4*)(rowp + bj * HALF) = w; } }
    }
};

constexpr float RMS_EPS_F = 1e-6f;
typedef unsigned u32x2 __attribute__((ext_vector_type(2)));
struct EpiUp {
    static constexpr bool PERM = true, AFTER_DRAIN = false;
    bf16_t* O; int ldc; const float* ss;
    __device__ __forceinline__ void operator()(const f32x4 (&acc)[2][2][4][2], const Unit& u, int wr, int wc, int fr, int fq) const {
        const int row0 = u.pm * BM + wr * 64 + fr; const int col0 = u.pn * BM + wc * 32 + 8 * fq;
#pragma unroll
        for (int ai = 0; ai < 2; ++ai)
#pragma unroll
            for (int m = 0; m < 4; ++m) { const int row = row0 + ai * HALF + m * 16; const f32x4 s4 = *(const f32x4*)(ss + (size_t)row * 4);
                const float rstd = __builtin_amdgcn_rsqf(((s4[0] + s4[1]) + (s4[2] + s4[3])) * (1.0f / 1024.0f) + RMS_EPS_F);
                bf16_t* rowp = O + (size_t)row * ldc + col0;
#pragma unroll
                for (int bj = 0; bj < 2; ++bj) { f32x4 v0 = acc[ai][bj][m][0] * rstd, v1 = acc[ai][bj][m][1] * rstd;
#pragma unroll
                    for (int j = 0; j < 4; ++j) { const float a = fmaxf(v0[j], 0.f), b = fmaxf(v1[j], 0.f); v0[j] = a * a; v1[j] = b * b; }
                    u32x4 w; w.x = cvt_pk_bf16(v0[0], v0[1]); w.y = cvt_pk_bf16(v0[2], v0[3]); w.z = cvt_pk_bf16(v1[0], v1[1]); w.w = cvt_pk_bf16(v1[2], v1[3]);
                    *(u32x4*)(rowp + bj * HALF) = w; } }
    }
};
struct EpiRes {
    static constexpr bool PERM = false, AFTER_DRAIN = true;
    const float* base; float* out; bf16_t* xn; float* ss;
    __device__ __forceinline__ void fused(f32x4 (&acc)[2][2][4][2], const Unit& u, int wr, int wc, int fr, int fq, PG8_LAS unsigned char* lds, int wid, int lane) const {
        PG8_LAS float* P = (PG8_LAS float*)lds;
        const int col0 = u.pn * BM + wc * 32 + 4 * fq;
#pragma unroll
        for (int ai = 0; ai < 2; ++ai)
#pragma unroll
            for (int m = 0; m < 4; ++m) { const int r = ai * HALF + wr * 64 + m * 16 + fr; const size_t off = (size_t)(u.pm * BM + r) * 1024 + col0; float s = 0.f;
#pragma unroll
                for (int bj = 0; bj < 2; ++bj)
#pragma unroll
                    for (int n = 0; n < 2; ++n) { const f32x4 bs = *(const f32x4*)(base + off + bj * HALF + n * 16); const f32x4 hv = bs + acc[ai][bj][m][n];
                        *(f32x4*)(out + off + bj * HALF + n * 16) = hv; s += (hv[0] * hv[0] + hv[1] * hv[1]) + (hv[2] * hv[2] + hv[3] * hv[3]);
                        u32x2 w; w.x = cvt_pk_bf16(hv[0], hv[1]); w.y = cvt_pk_bf16(hv[2], hv[3]); *(u32x2*)(xn + off + bj * HALF + n * 16) = w; }
                s += __shfl_xor(s, 16); s += __shfl_xor(s, 32);
                if (fq == 0) P[r * 4 + wc] = s;
                if (m & 1) asm volatile("" ::: "memory"); }
        asm volatile("s_waitcnt lgkmcnt(0)" ::: "memory"); __builtin_amdgcn_s_barrier(); asm volatile("" ::: "memory");
        const int t = wid * 64 + lane;
        if (t < 256) { const PG8_LAS f32x4* P4 = (const PG8_LAS f32x4*)lds; const f32x4 p = P4[t]; ss[(size_t)(u.pm * BM + t) * 4 + u.pn] = (p[0] + p[1]) + (p[2] + p[3]); }
    }
};
struct EpiGate {
    static constexpr bool PERM = false, AFTER_DRAIN = true;
    float* hio; const bf16_t* pp; const float* bg; const float* ss;
    __device__ __forceinline__ void fused(f32x4 (&acc)[2][2][4][2], const Unit& u, int wr, int wc, int fr, int fq, PG8_LAS unsigned char* lds, int wid, int lane) const {
        const int col0 = u.pn * BM + wc * 32 + 4 * fq;
        f32x4 bv[2][2];
#pragma unroll
        for (int bj = 0; bj < 2; ++bj)
#pragma unroll
            for (int n = 0; n < 2; ++n) bv[bj][n] = *(const f32x4*)(bg + col0 + bj * HALF + n * 16);
#pragma unroll
        for (int ai = 0; ai < 2; ++ai)
#pragma unroll
            for (int m = 0; m < 4; ++m) { const int row = u.pm * BM + ai * HALF + wr * 64 + m * 16 + fr; const size_t off = (size_t)row * 1024 + col0;
                const f32x4 s4 = *(const f32x4*)(ss + (size_t)row * 4);
                const float rstd = __builtin_amdgcn_rsqf(((s4[0] + s4[1]) + (s4[2] + s4[3])) * (1.0f / 1024.0f) + RMS_EPS_F);
#pragma unroll
                for (int bj = 0; bj < 2; ++bj)
#pragma unroll
                    for (int n = 0; n < 2; ++n) { const f32x4 z = acc[ai][bj][m][n] * rstd + bv[bj][n]; const u32x2 pw = *(const u32x2*)(pp + off + bj * HALF + n * 16);
                        const f32x4 h2 = *(const f32x4*)(hio + off + bj * HALF + n * 16);
                        f32x4 pv; pv[0] = __uint_as_float(pw.x << 16); pv[1] = __uint_as_float(pw.x & 0xffff0000u); pv[2] = __uint_as_float(pw.y << 16); pv[3] = __uint_as_float(pw.y & 0xffff0000u);
                        f32x4 o;
#pragma unroll
                        for (int j = 0; j < 4; ++j) { const float g = __builtin_amdgcn_rcpf(1.0f + __expf(-z[j])); o[j] = h2[j] + g * pv[j]; }
                        *(f32x4*)(hio + off + bj * HALF + n * 16) = o; }
                if (m & 1) asm volatile("" ::: "memory"); }
    }
};
template <class Epi, class Sched, bool ALIGN_EPI = false, bool SP2 = false>
__device__ __forceinline__ void gemm_phase(PG8_LAS unsigned char* lds, const Gemm g, const Sched& S, const Epi& E) {
    const int tid = threadIdx.x, wid = __builtin_amdgcn_readfirstlane(tid >> 6), lane = tid & 63, wr = wid >> 2, wc = wid & 3, fr = lane & 15, fq = lane >> 4;
    const int K = g.K, nt = K / BK;
    unsigned voffA[2], voffB[2];
#pragma unroll
    for (int i = 0; i < 2; ++i) { int R, C; stage_rc(tid * 16 + i * 8192, R, C); const int Rb = Epi::PERM ? ((R & ~31) + perm32(R & 31)) : R;
        voffA[i] = (unsigned)(R * K + C) * 2u; voffB[i] = (unsigned)(Rb * K + C) * 2u; }
    const size_t kstep = (size_t)(BK * 2);
    const size_t hstep = (size_t)HALF * K * 2;
    const size_t tstep = 2 * hstep;
    const unsigned ldsw = (unsigned)wid * 1024u;
    const int aoff = lds_byte(wr * 64 + fr, fq * 8), boff = lds_byte(wc * 32 + fr, fq * 8);
#define PG8_SA(b, h) (((b) * 2 + (h)) * HTB)
#define PG8_SB(b, h) ((4 + (b) * 2 + (h)) * HTB)
#define PG8_STAGE(bufoff, gbase, voff) do { _Pragma("unroll") for (int _i = 0; _i < 2; ++_i) \
        __builtin_amdgcn_global_load_lds((const unsigned*)((const char*)(gbase) + (voff)[_i]), (PG8_LAS unsigned*)(lds + (bufoff) + ldsw + _i * 8192), 16, 0, 0); } while (0)
#define PG8_LDA(dst, b, h) do { _Pragma("unroll") for (int m = 0; m < 4; ++m) _Pragma("unroll") for (int k = 0; k < 2; ++k) dst[m][k] = *(const PG8_LAS bf16x8*)(lds + PG8_SA(b, h) + aoff + m * 2048 + k * 1024); } while (0)
#define PG8_LDB(dst, b, h) do { _Pragma("unroll") for (int n = 0; n < 2; ++n) _Pragma("unroll") for (int k = 0; k < 2; ++k) dst[n][k] = *(const PG8_LAS bf16x8*)(lds + PG8_SB(b, h) + boff + n * 2048 + k * 1024); } while (0)
#define PG8_MMA(ai, bj, At, Bt) do { __builtin_amdgcn_s_setprio(1); _Pragma("unroll") for (int m = 0; m < 4; ++m) _Pragma("unroll") for (int n = 0; n < 2; ++n) _Pragma("unroll") for (int k = 0; k < 2; ++k) \
        acc[ai][bj][m][n] = __builtin_amdgcn_mfma_f32_16x16x32_bf16(Bt[n][k], At[m][k], acc[ai][bj][m][n], 0, 0, 0); __builtin_amdgcn_s_setprio(0); } while (0)
#define PG8_WAIT_V(n) asm volatile("s_waitcnt vmcnt(" #n ")" ::: "memory")
#define PG8_WAIT_L(n) asm volatile("s_waitcnt lgkmcnt(" #n ")" ::: "memory")
#define PG8_BAR __builtin_amdgcn_s_barrier()
#define PG8_SCHED __builtin_amdgcn_sched_barrier(0)
    Unit cur, nxt; int ui = 0;
    if (!S.next(0, cur)) return;
    f32x4 acc[2][2][4][2];
#pragma unroll
    for (int a = 0; a < 2; ++a)
#pragma unroll
        for (int b = 0; b < 2; ++b)
#pragma unroll
            for (int m = 0; m < 4; ++m)
#pragma unroll
                for (int n = 0; n < 2; ++n) acc[a][b][m][n] = (f32x4){0.f, 0.f, 0.f, 0.f};
    bf16x8 At[4][2], B0[2][2], B1[2][2];
    const char* cA = (const char*)g.A + (size_t)cur.pm * tstep; const char* cB = (const char*)g.Bt + (size_t)cur.pn * tstep;
    S.a_ready(cur);
    if constexpr (SP2) {
        PG8_STAGE(PG8_SB(0, 0), cB, voffB); PG8_STAGE(PG8_SB(0, 1), cB + hstep, voffB); PG8_STAGE(PG8_SA(0, 0), cA, voffA); PG8_STAGE(PG8_SA(0, 1), cA + hstep, voffA);
        if (wr == 1) PG8_BAR;
        PG8_WAIT_V(2); PG8_BAR;
        PG8_STAGE(PG8_SB(1, 0), cB + kstep, voffB); PG8_STAGE(PG8_SA(1, 0), cA + kstep, voffA); PG8_STAGE(PG8_SB(1, 1), cB + hstep + kstep, voffB);
        PG8_WAIT_V(6); PG8_BAR;
    } else {
        PG8_STAGE(PG8_SB(0, 0), cB, voffB); PG8_STAGE(PG8_SA(0, 0), cA, voffA); PG8_STAGE(PG8_SB(0, 1), cB + hstep, voffB); PG8_STAGE(PG8_SA(0, 1), cA + hstep, voffA);
        if (wr == 1) PG8_BAR;
        PG8_WAIT_V(4); PG8_BAR;
        PG8_STAGE(PG8_SB(1, 0), cB + kstep, voffB); PG8_STAGE(PG8_SA(1, 0), cA + kstep, voffA); PG8_STAGE(PG8_SB(1, 1), cB + hstep + kstep, voffB);
        PG8_WAIT_V(6); PG8_BAR;
    }
    for (;;) {
        const bool has_next = S.next(ui + 1, nxt);
        const char* nA = has_next ? (const char*)g.A + (size_t)nxt.pm * tstep : cA; const char* nB = has_next ? (const char*)g.Bt + (size_t)nxt.pn * tstep : cB;
        for (int t = 0; t < nt; t += 2) {
            const bool last = (t == nt - 2);
            const char* a1 = cA + (size_t)(t + 1) * kstep;
            const char* a2 = last ? nA : cA + (size_t)(t + 2) * kstep; const char* b2 = last ? nB : cB + (size_t)(t + 2) * kstep;
            const char* a3 = a2 + kstep; const char* b3 = b2 + kstep;
            if (last && has_next) S.a_ready(nxt);
            if constexpr (SP2) {
            PG8_LDB(B0, 0, 0); PG8_LDB(B1, 0, 1); PG8_SCHED; PG8_LDA(At, 0, 0); PG8_STAGE(PG8_SA(1, 1), a1 + hstep, voffA);
            PG8_WAIT_V(8); PG8_WAIT_L(0); PG8_BAR; PG8_MMA(0, 0, At, B0); PG8_MMA(0, 1, At, B1); PG8_BAR; PG8_SCHED;
            PG8_LDA(At, 0, 1); PG8_STAGE(PG8_SB(0, 0), b2, voffB); PG8_STAGE(PG8_SB(0, 1), b2 + hstep, voffB); PG8_STAGE(PG8_SA(0, 0), a2, voffA);
            PG8_WAIT_V(8); PG8_WAIT_L(0); PG8_BAR; PG8_MMA(1, 0, At, B0); PG8_MMA(1, 1, At, B1); PG8_BAR; PG8_SCHED;
            PG8_LDB(B0, 1, 0); PG8_LDB(B1, 1, 1); PG8_SCHED; PG8_LDA(At, 1, 0); PG8_STAGE(PG8_SA(0, 1), a2 + hstep, voffA);
            PG8_WAIT_V(8); PG8_WAIT_L(0); PG8_BAR; PG8_MMA(0, 0, At, B0); PG8_MMA(0, 1, At, B1); PG8_BAR; PG8_SCHED;
            PG8_LDA(At, 1, 1); PG8_STAGE(PG8_SB(1, 0), b3, voffB); PG8_STAGE(PG8_SB(1, 1), b3 + hstep, voffB); PG8_STAGE(PG8_SA(1, 0), a3, voffA);
            PG8_WAIT_V(8); PG8_WAIT_L(0); PG8_BAR; PG8_MMA(1, 0, At, B0); PG8_MMA(1, 1, At, B1); PG8_BAR; PG8_SCHED;
            } else {
            PG8_LDB(B0, 0, 0); PG8_SCHED; PG8_LDA(At, 0, 0); PG8_STAGE(PG8_SA(1, 1), a1 + hstep, voffA);
            PG8_WAIT_L(8); PG8_BAR; PG8_WAIT_L(0); PG8_MMA(0, 0, At, B0); PG8_BAR; PG8_SCHED;
            PG8_LDB(B1, 0, 1); PG8_STAGE(PG8_SB(0, 0), b2, voffB);
            PG8_BAR; PG8_WAIT_L(0); PG8_MMA(0, 1, At, B1); PG8_BAR;
            PG8_LDA(At, 0, 1); PG8_STAGE(PG8_SA(0, 0), a2, voffA);
            PG8_BAR; PG8_WAIT_L(0); PG8_MMA(1, 0, At, B0); PG8_BAR; PG8_SCHED;
            PG8_STAGE(PG8_SB(0, 1), b2 + hstep, voffB);
            PG8_WAIT_V(6); PG8_BAR; PG8_MMA(1, 1, At, B1); PG8_BAR;
            PG8_LDB(B0, 1, 0); PG8_SCHED; PG8_LDA(At, 1, 0); PG8_STAGE(PG8_SA(0, 1), a2 + hstep, voffA);
            PG8_WAIT_L(8); PG8_BAR; PG8_WAIT_L(0); PG8_MMA(0, 0, At, B0); PG8_BAR; PG8_SCHED;
            PG8_LDB(B1, 1, 1); PG8_STAGE(PG8_SB(1, 0), b3, voffB);
            PG8_BAR; PG8_WAIT_L(0); PG8_MMA(0, 1, At, B1); PG8_BAR;
            PG8_LDA(At, 1, 1); PG8_STAGE(PG8_SA(1, 0), a3, voffA);
            PG8_BAR; PG8_WAIT_L(0); PG8_MMA(1, 0, At, B0); PG8_BAR; PG8_SCHED;
            PG8_STAGE(PG8_SB(1, 1), b3 + hstep, voffB);
            PG8_WAIT_V(6); PG8_BAR; PG8_MMA(1, 1, At, B1); PG8_BAR;
            }
        }
        if constexpr (ALIGN_EPI) { if (wr == 0) PG8_BAR; }
        if constexpr (!Epi::AFTER_DRAIN) { E(acc, cur, wr, wc, fr, fq); S.done(cur); }
        if (!has_next) break;
#pragma unroll
        for (int a = 0; a < 2; ++a)
#pragma unroll
            for (int b = 0; b < 2; ++b)
#pragma unroll
                for (int m = 0; m < 4; ++m)
#pragma unroll
                    for (int n = 0; n < 2; ++n) acc[a][b][m][n] = (f32x4){0.f, 0.f, 0.f, 0.f};
        cur = nxt; cA = nA; cB = nB; ++ui;
        if constexpr (ALIGN_EPI) { if (wr == 1) PG8_BAR; }
    }
    PG8_WAIT_V(0);
    if constexpr (!ALIGN_EPI) { if (wr == 0) PG8_BAR; }
    PG8_BAR;
    if constexpr (Epi::AFTER_DRAIN) { E.fused(acc, cur, wr, wc, fr, fq, lds, wid, lane); S.done(cur); }
#undef PG8_SA
#undef PG8_SB
#undef PG8_STAGE
#undef PG8_LDA
#undef PG8_LDB
#undef PG8_MMA
#undef PG8_WAIT_V
#undef PG8_WAIT_L
#undef PG8_BAR
#undef PG8_SCHED
}
}

#ifndef PG8_SP2
#define PG8_SP2 true
#endif
#ifndef PG8_ALIGN
#define PG8_ALIGN true
#endif

constexpr int NWAVES = 8;
#ifndef MK_N_LAUNCHES
#define MK_N_LAUNCHES 1
#endif
constexpr int PER_PHASE = 9;
constexpr int N_LAUNCHES = MK_N_LAUNCHES;
static_assert(N_LAUNCHES == 1 || N_LAUNCHES == PER_PHASE, "MK_N_LAUNCHES is 1 or 9");

constexpr int BATCH = 2, T = 8192, D = 1024, FF = 4096, DPOOL = 512, DLRU = 512, NPROJ = 1536, PLE = 256, NHEADS = 8, HB = 64;
constexpr int M = BATCH * T;
constexpr int TC = 64, NCH = T / TC;

constexpr size_t MiB = 1u << 20;
constexpr size_t WS_CTL = 0, CTL_ZERO_BYTES = 64 * 1024;
constexpr size_t WS_WIN = 1 * MiB, WS_WOUT = 4 * MiB, WS_WUP = 6 * MiB, WS_WDN = 14 * MiB, WS_WG = 22 * MiB, WS_WPP = 24 * MiB;
constexpr size_t WS_WGA = 24 * MiB + 512 * 1024, WS_WGX = WS_WGA + 64 * 1024;
constexpr size_t WS_SS1 = 25 * MiB, WS_SS2 = WS_SS1 + 256 * 1024;
constexpr size_t WS_AGG = 26 * MiB;
constexpr size_t WS_HMID = 32 * MiB;
constexpr size_t WS_PROJ = 32 * MiB, WS_Y = 80 * MiB;
constexpr size_t WS_XN = 160 * MiB;
constexpr size_t WS_PP = 192 * MiB;
constexpr size_t WS_PB = 224 * MiB;
constexpr size_t WS_END = 256 * MiB;
static_assert(WS_WPP + (size_t)D * PLE * 2 <= WS_WGA && WS_WGX + 64 * 1024 <= WS_SS1 && WS_SS2 + 256 * 1024 <= WS_AGG && WS_AGG + 1 * MiB <= WS_HMID, "d_ws map (small)");
static_assert(WS_PROJ + (size_t)M * NPROJ * 2 <= WS_Y && WS_Y + (size_t)M * D * 2 <= WS_XN && WS_HMID + (size_t)M * FF * 2 <= WS_XN && WS_XN + (size_t)M * D * 2 <= WS_PP && WS_PP + (size_t)M * D * 2 <= WS_PB && WS_PB + (size_t)M * PLE * 2 <= WS_END, "d_ws map");
constexpr int CW_TMO = 0, CW_CODE = 1;
constexpr int CW_BAR = 4096;

constexpr int RING_OFF = 0, RING_BYTES = 131072;
constexpr int LDSCTL_OFF = RING_BYTES, MISC_OFF = LDSCTL_OFF + 320;
constexpr int LDS_BYTES = 147456;
static_assert(MISC_OFF + 128 <= LDS_BYTES, "LDS map");
#define GAS __attribute__((address_space(1)))
#define LAS __attribute__((address_space(3)))
typedef unsigned short bf16;
typedef unsigned v4u __attribute__((ext_vector_type(4)));
typedef float f32x4 __attribute__((ext_vector_type(4)));
typedef short bf16x8 __attribute__((ext_vector_type(8)));
typedef GAS unsigned gu32;
typedef GAS unsigned long long gu64;
#define RLX_AGENT __ATOMIC_RELAXED, __HIP_MEMORY_SCOPE_AGENT
#define LDS_WAIT() asm volatile("s_waitcnt lgkmcnt(0)" ::: "memory")
#define VM_WAIT() asm volatile("s_waitcnt vmcnt(0)" ::: "memory")
__device__ __forceinline__ unsigned long long rt() { return __builtin_amdgcn_s_memrealtime(); }
__device__ __forceinline__ unsigned f2bf(float f) { unsigned u = __builtin_bit_cast(unsigned, f); return (u + 0x7fffu + ((u >> 16) & 1u)) >> 16; }
__device__ __forceinline__ unsigned pk2(float lo, float hi) { return f2bf(lo) | (f2bf(hi) << 16); }

#define XB_TMO      128
#define XB_XCNT(j)  (256  + 64 * (j))
#define XB_XSUB(j)  (1280 + 64 * (j))
#define XB_XGEN(j)  (2304 + 64 * (j))
#define XB_TOP      3328
#define XB_TOPGEN   3392
#define XCD_BAR_WORDS 3456
#define XB_SPIN_CAP (1u << 18)

__device__ __forceinline__ unsigned xb_ld(unsigned* p)              { return __hip_atomic_load(p, __ATOMIC_RELAXED, __HIP_MEMORY_SCOPE_AGENT); }
__device__ __forceinline__ unsigned xb_add(unsigned* p, unsigned v) { return __hip_atomic_fetch_add(p, v, __ATOMIC_RELAXED, __HIP_MEMORY_SCOPE_AGENT); }
__device__ __forceinline__ unsigned xb_xcc_id() { return (unsigned)__builtin_amdgcn_s_getreg((3 << 11) | 20) & 0xFu; }
#define XB_SPIN(cond, bar) do { unsigned _sp = 0; while (cond) { __builtin_amdgcn_s_sleep(1); \
    if ((++_sp & 255u) == 0u) { if (xb_ld(&(bar)[XB_TMO])) break; if (_sp > XB_SPIN_CAP) { atomicAdd(&(bar)[XB_TMO], 1u); break; } } } } while (0)

struct XcdBarrier {
    unsigned* bar; unsigned x;
    volatile LAS unsigned* st;
};

__device__ __forceinline__ XcdBarrier xcd_barrier_post(unsigned* bar, volatile LAS unsigned* st) {
    XcdBarrier b; b.bar = bar; b.x = xb_xcc_id(); b.st = st;
    if (threadIdx.x == 0) (void)xb_add(&bar[XB_XCNT(b.x)], 1u);
    return b;
}
__device__ __forceinline__ void xcd_barrier_complete(unsigned* bar, unsigned x, unsigned& nloc, unsigned& nx) {
    const unsigned G = gridDim.x * gridDim.y * gridDim.z;
    unsigned sum, cnt, mine, sp = 0u;
    for (;;) {
        sum = 0u; cnt = 0u; mine = 0u;
#pragma unroll
        for (unsigned j = 0; j < 16; ++j) { const unsigned c = xb_ld(&bar[XB_XCNT(j)]); sum += c; cnt += (c > 0u) ? 1u : 0u; mine = (j == x) ? c : mine; }
        if (sum == G) break;
        __builtin_amdgcn_s_sleep(1);
        if ((++sp & 255u) == 0u) { if (xb_ld(&bar[XB_TMO])) break; if (sp > XB_SPIN_CAP) { atomicAdd(&bar[XB_TMO], 1u); break; } }
    }
    nloc = mine > 0u ? mine : 1u; nx = cnt > 0u ? cnt : 1u;
}

__device__ __forceinline__ void xcd_barrier(const XcdBarrier& b) {
    asm volatile("s_waitcnt vmcnt(0)" ::: "memory");
    __syncthreads();
    if (threadIdx.x == 0) {
        unsigned* bar = b.bar;
        __builtin_amdgcn_s_waitcnt(0);
        unsigned nloc = b.st[0], nx = b.st[1];
        if (nloc == 0u) { xcd_barrier_complete(bar, b.x, nloc, nx); b.st[0] = nloc; b.st[1] = nx; }
        const unsigned old = xb_add(&bar[XB_XSUB(b.x)], 1u);
        const unsigned gen = old / nloc;
        if (old + 1u == (gen + 1u) * nloc) {
            __builtin_amdgcn_fence(__ATOMIC_RELEASE, "agent");
            asm volatile("s_waitcnt vmcnt(0)" ::: "memory");
            const unsigned og = xb_add(&bar[XB_TOP], 1u);
            const unsigned tg = og / nx;
            if (og + 1u == (tg + 1u) * nx) xb_add(&bar[XB_TOPGEN], 1u);
            else XB_SPIN(xb_ld(&bar[XB_TOPGEN]) == tg, bar);
            __builtin_amdgcn_fence(__ATOMIC_ACQUIRE, "agent");
            xb_add(&bar[XB_XGEN(b.x)], 1u);
            asm volatile("s_waitcnt vmcnt(0)" ::: "memory");
        } else {
            XB_SPIN(xb_ld(&bar[XB_XGEN(b.x)]) == gen, bar);
            __builtin_amdgcn_fence(__ATOMIC_ACQUIRE, "agent");
            asm volatile("s_waitcnt vmcnt(0)" ::: "memory");
        }
    }
    __syncthreads();
}

typedef float f32x2 __attribute__((ext_vector_type(2)));

struct Frame {
    LAS unsigned char* lds;
    volatile LAS unsigned* MISC;
    gu32* ctl;
    int tid, lane, wave;
    int vcu, G;
    const float *x, *p, *g_mix, *w_in, *pool_w, *pool_b, *pool_scale, *conv_w, *conv_b, *ga_w, *ga_b, *gx_w, *gx_b, *lru_L, *w_out, *g_mlp, *w_up, *w_down, *g_ple, *w_gate, *b_gate, *w_pp, *g_final;
    float* out;
    bf16 *Win_t, *Wout_t, *Wup_t, *Wdn_t, *Wg_t, *Wpp_t, *Wga_t, *Wgx_t;
    bf16 *PROJ, *Y, *HMID, *XN, *PP, *PB;
    float *SS1, *SS2, *AGG;
};

__device__ __forceinline__ float wave_sum(float v) {
#pragma unroll
    for (int o = 1; o < 64; o <<= 1) v += __shfl_xor(v, o);
    return v;
}
__device__ __forceinline__ float bflo(unsigned w) { return __uint_as_float(w << 16); }
__device__ __forceinline__ float bfhi(unsigned w) { return __uint_as_float(w & 0xffff0000u); }
__device__ __forceinline__ void p0_transpose_item(const float* W, int ldw, int ncols, const float* kscale, bf16* WT, int ldt, LAS float* scr, int item, int lane) {
    const int nblk = ncols / 32, kb = item / nblk, nb = item % nblk, k0 = 64 * kb, n0 = 32 * nb;
#pragma unroll 8
    for (int i = 0; i < 32; ++i) { const int kk = 2 * i + (lane >> 5); float v = W[(size_t)(k0 + kk) * ldw + n0 + (lane & 31)]; if (kscale) v *= kscale[k0 + kk]; scr[kk * 33 + (lane & 31)] = v; }
    LDS_WAIT(); asm volatile("" ::: "memory");
    const int c = lane & 7;
#pragma unroll
    for (int j = 0; j < 4; ++j) { const int n = (lane >> 3) + 8 * j; const LAS float* s = scr + (8 * c) * 33 + n;
        v4u o; o.x = pk2(s[0 * 33], s[1 * 33]); o.y = pk2(s[2 * 33], s[3 * 33]); o.z = pk2(s[4 * 33], s[5 * 33]); o.w = pk2(s[6 * 33], s[7 * 33]);
        *(GAS v4u*)(WT + (size_t)(n0 + n) * ldt + k0 + 8 * c) = o; }
    LDS_WAIT(); asm volatile("" ::: "memory");
}
__device__ __forceinline__ void p0_poolfold_item(const float* w_in, const float* pool_w, bf16* Win_t, int item, int lane) {
    const int kb = item >> 4, nb = item & 15, k0 = 8 * kb, n0 = 32 * nb, g = n0 >> 7, nl = (n0 & 127) + (lane & 31), kk2 = lane >> 5;
    float acc[4] = {0.f, 0.f, 0.f, 0.f};
    const float* pw = pool_w + (size_t)g * 16384 + nl;
    const float* wi = w_in + (size_t)(k0 + kk2) * NPROJ + 128 * g;
#pragma unroll 4
    for (int j4 = 0; j4 < 32; ++j4) {
        const float p0 = pw[(4 * j4 + 0) * 128], p1 = pw[(4 * j4 + 1) * 128], p2 = pw[(4 * j4 + 2) * 128], p3 = pw[(4 * j4 + 3) * 128];
#pragma unroll
        for (int i = 0; i < 4; ++i) { const f32x4 w = *(const f32x4*)(wi + (size_t)(2 * i) * NPROJ + 4 * j4); acc[i] += (w[0] * p0 + w[1] * p1) + (w[2] * p2 + w[3] * p3); }
    }
    float o[4];
#pragma unroll
    for (int i = 0; i < 4; ++i) o[i] = __shfl_xor(acc[i], 32);
    if (lane < 32) { v4u w; w.x = pk2(acc[0], o[0]); w.y = pk2(acc[1], o[1]); w.z = pk2(acc[2], o[2]); w.w = pk2(acc[3], o[3]);
        *(GAS v4u*)(Win_t + (size_t)(n0 + lane) * D + k0) = w; }
}
__device__ __forceinline__ void rms_row_to_bf16(const float* xrow, const float* g, bf16* orow, int lane) {
    const GAS f32x4* xr = (const GAS f32x4*)xrow + lane; const GAS f32x4* gr = (const GAS f32x4*)g + lane;
    f32x4 v[4]; float s = 0.f;
#pragma unroll
    for (int j = 0; j < 4; ++j) { v[j] = xr[64 * j]; s += (v[j][0] * v[j][0] + v[j][1] * v[j][1]) + (v[j][2] * v[j][2] + v[j][3] * v[j][3]); }
    const float rstd = 1.f / sqrtf(wave_sum(s) * (1.f / D) + 1e-6f);
    GAS unsigned long long* o8 = (GAS unsigned long long*)orow + lane;
#pragma unroll
    for (int j = 0; j < 4; ++j) { const f32x4 gg = gr[64 * j]; o8[64 * j] = (unsigned long long)pk2(v[j][0] * rstd * gg[0], v[j][1] * rstd * gg[1]) | ((unsigned long long)pk2(v[j][2] * rstd * gg[2], v[j][3] * rstd * gg[3]) << 32); }
}
__device__ __forceinline__ void rms_row_f32(float* row, const float* g, int lane) {
    GAS f32x4* xr = (GAS f32x4*)row + lane; const GAS f32x4* gr = (const GAS f32x4*)g + lane;
    f32x4 v[4]; float s = 0.f;
#pragma unroll
    for (int j = 0; j < 4; ++j) { v[j] = xr[64 * j]; s += (v[j][0] * v[j][0] + v[j][1] * v[j][1]) + (v[j][2] * v[j][2] + v[j][3] * v[j][3]); }
    const float rstd = 1.f / sqrtf(wave_sum(s) * (1.f / D) + 1e-6f);
#pragma unroll
    for (int j = 0; j < 4; ++j) { const f32x4 gg = gr[64 * j]; xr[64 * j] = (v[j] * rstd) * gg; }
}
__device__ __forceinline__ void p0_prologue(Frame& F) {
    LAS float* scr = (LAS float*)(F.lds + RING_OFF + F.wave * 16384);
    const int gw = F.vcu * NWAVES + F.wave, NGW = F.G * NWAVES;
    constexpr int I_IN = (D / 64) * (1024 / 32), I_OUT = (D / 64) * (D / 32), I_UP = (D / 64) * (FF / 32), I_DN = (FF / 64) * (D / 32), I_G = (D / 64) * (D / 32), I_PP = (PLE / 64) * (D / 32), I_GA = 16, I_GX = 16;
    constexpr int NT = I_IN + I_OUT + I_UP + I_DN + I_G + I_PP + I_GA + I_GX, I_FOLD = 2048;
    for (int it = gw; it < NT + I_FOLD; it += NGW) {
        int r = it;
        if (r < I_IN) { p0_transpose_item(F.w_in + 512, NPROJ, 1024, nullptr, F.Win_t + (size_t)512 * D, D, scr, r, F.lane); continue; } r -= I_IN;
        if (r < I_OUT) { p0_transpose_item(F.w_out, D, D, nullptr, F.Wout_t, D, scr, r, F.lane); continue; } r -= I_OUT;
        if (r < I_UP) { p0_transpose_item(F.w_up, FF, FF, F.g_mlp, F.Wup_t, D, scr, r, F.lane); continue; } r -= I_UP;
        if (r < I_DN) { p0_transpose_item(F.w_down, D, D, nullptr, F.Wdn_t, FF, scr, r, F.lane); continue; } r -= I_DN;
        if (r < I_G) { p0_transpose_item(F.w_gate, D, D, F.g_ple, F.Wg_t, D, scr, r, F.lane); continue; } r -= I_G;
        if (r < I_PP) { p0_transpose_item(F.w_pp, D, D, nullptr, F.Wpp_t, PLE, scr, r, F.lane); continue; } r -= I_PP;
        if (r < I_GA) { p0_transpose_item(F.ga_w + (size_t)(r >> 1) * 4096, 64, 64, nullptr, F.Wga_t + (size_t)(r >> 1) * 4096, 64, scr, r & 1, F.lane); continue; } r -= I_GA;
        if (r < I_GX) { p0_transpose_item(F.gx_w + (size_t)(r >> 1) * 4096, 64, 64, nullptr, F.Wgx_t + (size_t)(r >> 1) * 4096, 64, scr, r & 1, F.lane); continue; } r -= I_GX;
        p0_poolfold_item(F.w_in, F.pool_w, F.Win_t, r, F.lane);
    }
    for (int m = gw; m < M; m += NGW) {
        rms_row_to_bf16(F.x + (size_t)m * D, F.g_mix, F.XN + (size_t)m * D, F.lane);
        const f32x4 pv = *((const GAS f32x4*)(F.p + (size_t)m * PLE) + F.lane);
        *((GAS unsigned long long*)(F.PB + (size_t)m * PLE) + F.lane) = (unsigned long long)pk2(pv[0], pv[1]) | ((unsigned long long)pk2(pv[2], pv[3]) << 32);
    }
}

typedef float f32x16 __attribute__((ext_vector_type(16)));
template <class Tv> __device__ __forceinline__ Tv gld(const void* base, unsigned off) { return *(const GAS Tv*)((const GAS char*)base + off); }
__device__ __forceinline__ float sigmoidf_(float z) { return __builtin_amdgcn_rcpf(1.0f + __expf(-z)); }
__device__ __forceinline__ float gelu_tanh(float v) { const float y = 0.7978845608028654f * (v + 0.044715f * v * v * v); const float t = 1.0f - 2.0f * __builtin_amdgcn_rcpf(1.0f + __expf(2.0f * y)); return 0.5f * v * (1.0f + t); }
template <int W>
__device__ __forceinline__ void pool_wave(const bf16* vbase, bf16* ybase, int tb, int ch, float pb0, float pb1, float ps0, float ps1) {
    unsigned raw[W + 31];
#pragma unroll
    for (int i = 0; i < W + 31; ++i) { const int tt = tb - (W - 1) + i; const unsigned rv = *(const GAS unsigned*)(vbase + (size_t)(tt >= 0 ? tt : 0) * NPROJ + ch); raw[i] = (tt >= 0) ? rv : 0u; }
    float s0 = 0.f, s1 = 0.f;
#pragma unroll
    for (int i = 0; i < W - 1; ++i) { s0 += bflo(raw[i]); s1 += bfhi(raw[i]); }
#pragma unroll
    for (int o = 0; o < 32; ++o) {
        const float c0 = bflo(raw[o + W - 1]), c1 = bfhi(raw[o + W - 1]); s0 += c0; s1 += c1;
        const int tt = tb + o; const float inv = 1.0f / (float)((tt + 1 < W) ? (tt + 1) : W);
        const float y0 = ((s0 * inv - c0) + pb0) * ps0, y1 = ((s1 * inv - c1) + pb1) * ps1;
        *(GAS unsigned*)(ybase + (size_t)tt * D + ch) = pk2(y0, y1);
        s0 -= bflo(raw[o]); s1 -= bfhi(raw[o]);
    }
}
template <int MODE>
__device__ __forceinline__ void mixer_phase(Frame& F) {
    const int lane = F.lane, l31 = lane & 31, hh = lane >> 5, w = F.wave;
    { const int unit = blockIdx.x; if (unit >= BATCH * NCH) return;
        const int b = unit / NCH, c = unit % NCH, t0 = c * TC;
        const bf16* projb = F.PROJ + (size_t)b * T * NPROJ; bf16* yb = F.Y + (size_t)b * T * D;
#ifndef NO_POOL
        if (MODE == 0) {
            const int g = w & 3, th = w >> 2, ch = 128 * g + 2 * lane, tb = t0 + 32 * th;
            const float pb0 = F.pool_b[ch], pb1 = F.pool_b[ch + 1], ps0 = F.pool_scale[ch], ps1 = F.pool_scale[ch + 1];
            if (g == 0) pool_wave<2>(projb, yb, tb, ch, pb0, pb1, ps0, ps1);
            else if (g == 1) pool_wave<4>(projb, yb, tb, ch, pb0, pb1, ps0, ps1);
            else if (g == 2) pool_wave<8>(projb, yb, tb, ch, pb0, pb1, ps0, ps1);
            else pool_wave<16>(projb, yb, tb, ch, pb0, pb1, ps0, ps1);
        }
#endif
        asm volatile("" ::: "memory"); __builtin_amdgcn_sched_barrier(0);
#ifndef NO_LRU
        const int h = w;
        float ba[2], bx[2], cL[2], carry[2] = {0.f, 0.f}, atot[2] = {1.f, 1.f};
        const unsigned lane_c4 = (unsigned)l31 * 4u;
        { const char* gab = (const char*)(F.ga_b + 64 * h); const char* gxb = (const char*)(F.gx_b + 64 * h); const char* lL = (const char*)(F.lru_L + 64 * h);
#pragma unroll
          for (int cb = 0; cb < 2; ++cb) { ba[cb] = gld<float>(gab, lane_c4 + 128u * cb); bx[cb] = gld<float>(gxb, lane_c4 + 128u * cb); cL[cb] = -8.0f * log1pf(__expf(-gld<float>(lL, lane_c4 + 128u * cb))); } }
        if (MODE == 1) {
            const int mid = c >> 1, lo_ = hh ? mid : 0, hi_ = hh ? c : mid;
            float A[2] = {1.f, 1.f}, B[2] = {0.f, 0.f};
            const char* ag = (const char*)(F.AGG + ((size_t)(b * NCH) * DLRU + 64 * h) * 2);
            unsigned ao = (unsigned)lo_ * (DLRU * 8u) + (unsigned)l31 * 8u;
#pragma unroll 8
            for (int cp = lo_; cp < hi_; ++cp, ao += DLRU * 8u) {
#pragma unroll
                for (int cb = 0; cb < 2; ++cb) { const f32x2 v = gld<f32x2>(ag, ao + 256u * cb); B[cb] = v[0] * B[cb] + v[1]; A[cb] *= v[0]; } }
#pragma unroll
            for (int cb = 0; cb < 2; ++cb) { const float pA = __shfl_xor(A[cb], 32), pB = __shfl_xor(B[cb], 32); carry[cb] = hh ? (A[cb] * pB + B[cb]) : (pA * B[cb] + pB); }
        }
        LAS float* tile = (LAS float*)(F.lds + RING_OFF + w * 8704);
        const char* cwb = (const char*)(F.conv_w + 64 * h); const char* cbb = (const char*)(F.conv_b + 64 * h);
        const char* wga = (const char*)(F.Wga_t + (size_t)h * 4096); const char* wgx = (const char*)(F.Wgx_t + (size_t)h * 4096);
        const unsigned lane_a4 = (unsigned)hh * 32u;
        const unsigned lane_w = (unsigned)(l31 * 64 + 8 * hh) * 2u;
#pragma unroll 1
        for (int rb = 0; rb < 2; ++rb) {
            const int tt = t0 + 32 * rb + l31;
            const char* pj = (const char*)(projb + DPOOL + 64 * h);
            unsigned offk[4]; bool okk[4];
#pragma unroll
            for (int k = 0; k < 4; ++k) { const int ts = tt - 3 + k; okk[k] = ts >= 0; offk[k] = (unsigned)(ts >= 0 ? ts : 0) * (NPROJ * 2u) + (unsigned)hh * 16u; }
            bf16x8 Af[4];
#pragma unroll
            for (int ks = 0; ks < 4; ++ks) {
                f32x4 x0 = gld<f32x4>(cbb, lane_a4 + 64u * ks), x1 = gld<f32x4>(cbb, lane_a4 + 64u * ks + 16u);
#pragma unroll
                for (int k = 0; k < 4; ++k) {
                    v4u raw = gld<v4u>(pj, offk[k] + 32u * ks); if (!okk[k]) raw = (v4u){0u, 0u, 0u, 0u};
                    const f32x4 w0 = gld<f32x4>(cwb, lane_a4 + 2048u * k + 64u * ks), w1 = gld<f32x4>(cwb, lane_a4 + 2048u * k + 64u * ks + 16u);
                    x0[0] += w0[0] * bflo(raw.x); x0[1] += w0[1] * bfhi(raw.x); x0[2] += w0[2] * bflo(raw.y); x0[3] += w0[3] * bfhi(raw.y);
                    x1[0] += w1[0] * bflo(raw.z); x1[1] += w1[1] * bfhi(raw.z); x1[2] += w1[2] * bflo(raw.w); x1[3] += w1[3] * bfhi(raw.w);
                }
                *(LAS f32x4*)(tile + l31 * 68 + 16 * ks + 8 * hh) = x0; *(LAS f32x4*)(tile + l31 * 68 + 16 * ks + 8 * hh + 4) = x1;
                v4u pk; pk.x = pk2(x0[0], x0[1]); pk.y = pk2(x0[2], x0[3]); pk.z = pk2(x1[0], x1[1]); pk.w = pk2(x1[2], x1[3]);
                Af[ks] = __builtin_bit_cast(bf16x8, pk);
                asm volatile("" ::: "memory");
            }
#pragma unroll
            for (int cb = 0; cb < 2; ++cb) {
                f32x16 aR, aI;
#pragma unroll
                for (int e = 0; e < 16; ++e) { aR[e] = 0.f; aI[e] = 0.f; }
#pragma unroll
                for (int ks = 0; ks < 4; ++ks) {
                    const bf16x8 Ba = gld<bf16x8>(wga, lane_w + 4096u * cb + 32u * ks), Bx = gld<bf16x8>(wgx, lane_w + 4096u * cb + 32u * ks);
                    aR = __builtin_amdgcn_mfma_f32_32x32x16_bf16(Af[ks], Ba, aR, 0, 0, 0);
                    aI = __builtin_amdgcn_mfma_f32_32x32x16_bf16(Af[ks], Bx, aI, 0, 0, 0);
                }
                asm volatile("" ::: "memory");
                float av[16], bv[16];
#pragma unroll
                for (int e = 0; e < 16; ++e) {
                    const int tok = (e & 3) + 8 * (e >> 2) + 4 * hh;
                    const float xb = tile[tok * 68 + 32 * cb + l31];
                    const float r = sigmoidf_(aR[e] + ba[cb]), ig = sigmoidf_(aI[e] + bx[cb]);
                    const float a = __expf(cL[cb] * r); float mult = sqrtf(fmaxf(1.0f - a * a, 0.f));
                    if (t0 + 32 * rb + tok == 0) mult = 1.0f;
                    av[e] = a; bv[e] = mult * ig * xb;
                }
                float Aq[4], Bq[4], pAq[4], pBq[4], cq[4];
#pragma unroll
                for (int q = 0; q < 4; ++q) { const float a0 = av[4 * q], a1 = av[4 * q + 1], a2 = av[4 * q + 2], a3 = av[4 * q + 3];
                    Aq[q] = (a0 * a1) * (a2 * a3); Bq[q] = ((bv[4 * q] * a1 + bv[4 * q + 1]) * a2 + bv[4 * q + 2]) * a3 + bv[4 * q + 3];
                    pAq[q] = __shfl_xor(Aq[q], 32); pBq[q] = __shfl_xor(Bq[q], 32); }
                float s = carry[cb];
#pragma unroll
                for (int q = 0; q < 4; ++q) { const float A0 = hh ? pAq[q] : Aq[q], B0 = hh ? pBq[q] : Bq[q], A1 = hh ? Aq[q] : pAq[q], B1 = hh ? Bq[q] : pBq[q];
                    const float s0 = s, s1 = A0 * s0 + B0; s = A1 * s1 + B1; cq[q] = hh ? s1 : s0; if (MODE == 0) atot[cb] *= A0 * A1; }
                carry[cb] = s;
                if (MODE == 1) {
                    const char* ugp = (const char*)(projb + (size_t)(t0 + 32 * rb) * NPROJ + DPOOL + DLRU + 64 * h + 32 * cb);
                    char* yp = (char*)(yb + (size_t)(t0 + 32 * rb) * D + DPOOL + 64 * h + 32 * cb);
                    const unsigned lane_ug = (unsigned)hh * (4u * NPROJ * 2u) + (unsigned)l31 * 2u, lane_y = (unsigned)hh * (4u * D * 2u) + (unsigned)l31 * 2u;
#pragma unroll
                    for (int q = 0; q < 4; ++q) { float hp = cq[q];
#pragma unroll
                        for (int i = 0; i < 4; ++i) { const int e = 4 * q + i; hp = av[e] * hp + bv[e];
                            const float ug = __uint_as_float((unsigned)gld<unsigned short>(ugp, lane_ug + (unsigned)(i + 8 * q) * (NPROJ * 2u)) << 16);
                            *(GAS unsigned short*)((GAS char*)yp + lane_y + (unsigned)(i + 8 * q) * (D * 2u)) = (unsigned short)f2bf(hp * gelu_tanh(ug)); } }
                }
            }
        }
        if (MODE == 0 && hh == 0) {
            char* agw = (char*)(F.AGG + ((size_t)(b * NCH + c) * DLRU + 64 * h) * 2);
#pragma unroll
            for (int cb = 0; cb < 2; ++cb) { f32x2 v; v[0] = atot[cb]; v[1] = carry[cb]; *(GAS f32x2*)((GAS char*)agw + (unsigned)l31 * 8u + 256u * cb) = v; }
        }
#endif
    }
}

struct Args { const float* in[23]; float* out; unsigned char* ws; int ph_lo, ph_hi; };
__global__ void __launch_bounds__(NWAVES * 64, 2) mk_fwd(Args args) {
    extern __shared__ __attribute__((aligned(16))) unsigned char lds[];
    Frame F;
    F.lds = (LAS unsigned char*)lds;
    F.MISC = (volatile LAS unsigned*)(F.lds + MISC_OFF);
    F.tid = threadIdx.x; F.lane = F.tid & 63; F.wave = __builtin_amdgcn_readfirstlane(F.tid >> 6);
    F.G = gridDim.x; { const int bx = blockIdx.x; F.vcu = (F.G % 8 == 0) ? (bx % 8) * (F.G / 8) + bx / 8 : bx; }
    unsigned char* ws = args.ws;
    F.ctl = (gu32*)(ws + WS_CTL);
    F.x = args.in[0]; F.p = args.in[1]; F.g_mix = args.in[2]; F.w_in = args.in[3]; F.pool_w = args.in[4]; F.pool_b = args.in[5]; F.pool_scale = args.in[6]; F.conv_w = args.in[7]; F.conv_b = args.in[8];
    F.ga_w = args.in[9]; F.ga_b = args.in[10]; F.gx_w = args.in[11]; F.gx_b = args.in[12]; F.lru_L = args.in[13]; F.w_out = args.in[14]; F.g_mlp = args.in[15]; F.w_up = args.in[16]; F.w_down = args.in[17];
    F.g_ple = args.in[18]; F.w_gate = args.in[19]; F.b_gate = args.in[20]; F.w_pp = args.in[21]; F.g_final = args.in[22]; F.out = args.out;
    F.Win_t = (bf16*)(ws + WS_WIN); F.Wout_t = (bf16*)(ws + WS_WOUT); F.Wup_t = (bf16*)(ws + WS_WUP); F.Wdn_t = (bf16*)(ws + WS_WDN); F.Wg_t = (bf16*)(ws + WS_WG); F.Wpp_t = (bf16*)(ws + WS_WPP);
    F.Wga_t = (bf16*)(ws + WS_WGA); F.Wgx_t = (bf16*)(ws + WS_WGX);
    F.PROJ = (bf16*)(ws + WS_PROJ); F.Y = (bf16*)(ws + WS_Y); F.HMID = (bf16*)(ws + WS_HMID); F.XN = (bf16*)(ws + WS_XN); F.PP = (bf16*)(ws + WS_PP); F.PB = (bf16*)(ws + WS_PB);
    F.SS1 = (float*)(ws + WS_SS1); F.SS2 = (float*)(ws + WS_SS2); F.AGG = (float*)(ws + WS_AGG);
    for (int u = F.tid; u < (LDS_BYTES - LDSCTL_OFF) / 4; u += NWAVES * 64) ((LAS unsigned*)(F.lds + LDSCTL_OFF))[u] = 0u;
    __syncthreads();
    XcdBarrier bar; bar.bar = (unsigned*)(F.ctl + CW_BAR); bar.x = 0; bar.st = nullptr;
    if (N_LAUNCHES == 1) bar = xcd_barrier_post((unsigned*)(F.ctl + CW_BAR), F.MISC + 8);
    const int lo = args.ph_lo, hi = args.ph_hi;
#ifdef ONLY_PHASE
#define IN(k) ((k) == ONLY_PHASE && lo <= (k) && (k) < hi)
#else
#define IN(k) (lo <= (k) && (k) < hi)
#endif
#define SEAM(k) do { if (IN(k) && IN((k) + 1)) xcd_barrier(bar); } while (0)

    if (IN(0)) { p0_prologue(F); } SEAM(0);
    if (IN(1)) {
        { pg8::Gemm g{F.XN, F.Win_t, M, NPROJ, D}; pg8::StaticOrder S; S.init(M, NPROJ, F.G, (int)blockIdx.x);
          pg8::EpiBf16<0> E{F.PROJ, NPROJ, nullptr, 0, 0, 1.f};
          pg8::gemm_phase<pg8::EpiBf16<0>, pg8::StaticOrder, PG8_ALIGN, PG8_SP2>(F.lds + RING_OFF, g, S, E); }
        { pg8::Gemm g{F.PB, F.Wpp_t, M, D, PLE}; pg8::StaticOrder S; S.init(M, D, F.G, (int)blockIdx.x);
          pg8::EpiBf16<0> E{F.PP, D, nullptr, 0, 0, 1.f};
          pg8::gemm_phase<pg8::EpiBf16<0>, pg8::StaticOrder, PG8_ALIGN, PG8_SP2>(F.lds + RING_OFF, g, S, E); }
    } SEAM(1);
    if (IN(2)) { mixer_phase<0>(F); } SEAM(2);
    if (IN(3)) { mixer_phase<1>(F); } SEAM(3);
    if (IN(4)) {
        pg8::Gemm g{F.Y, F.Wout_t, M, D, D}; pg8::StaticOrder S; S.init(M, D, F.G, (int)blockIdx.x);
        pg8::EpiRes E{F.x, F.out, F.XN, F.SS1};
        pg8::gemm_phase<pg8::EpiRes, pg8::StaticOrder, false, PG8_SP2>(F.lds + RING_OFF, g, S, E);
    } SEAM(4);
    if (IN(5)) {
        pg8::Gemm g{F.XN, F.Wup_t, M, FF, D}; pg8::StaticOrder S; S.init(M, FF, F.G, (int)blockIdx.x);
        pg8::EpiUp E{F.HMID, FF, F.SS1};
        pg8::gemm_phase<pg8::EpiUp, pg8::StaticOrder, PG8_ALIGN, PG8_SP2>(F.lds + RING_OFF, g, S, E);
    } SEAM(5);
    if (IN(6)) {
        pg8::Gemm g{F.HMID, F.Wdn_t, M, D, FF}; pg8::StaticOrder S; S.init(M, D, F.G, (int)blockIdx.x);
        pg8::EpiRes E{F.out, F.out, F.XN, F.SS2};
        pg8::gemm_phase<pg8::EpiRes, pg8::StaticOrder, false, PG8_SP2>(F.lds + RING_OFF, g, S, E);
    } SEAM(6);
    if (IN(7)) {
        pg8::Gemm g{F.XN, F.Wg_t, M, D, D}; pg8::StaticOrder S; S.init(M, D, F.G, (int)blockIdx.x);
        pg8::EpiGate E{F.out, F.PP, F.b_gate, F.SS2};
        pg8::gemm_phase<pg8::EpiGate, pg8::StaticOrder, false, PG8_SP2>(F.lds + RING_OFF, g, S, E);
    } SEAM(7);
    if (IN(8)) {
        const int gw = F.vcu * NWAVES + F.wave, NGW = F.G * NWAVES;
        for (int m = gw; m < M; m += NGW) rms_row_f32(F.out + (size_t)m * D, F.g_final, F.lane);
    }
#undef IN
#undef SEAM
}

extern "C" void kernel_launch(void* const* d_in, const int* in_sizes, int n_in, void* d_out, int out_size, void* d_ws, size_t ws_size, hipStream_t stream) {
    static int grid = 0;
    if (grid == 0) {
        if (n_in != 23 || in_sizes[0] != M * D || out_size != M * D || ws_size < WS_END) { fprintf(stderr, "kernel_launch: unexpected shapes (n_in %d, in0 %d, out %d, ws %zu); nothing launched\n", n_in, n_in > 0 ? in_sizes[0] : -1, out_size, ws_size); grid = -1; return; }
        int dev = 0, cus = 0, per_cu = 0;
        if (hipGetDevice(&dev) != hipSuccess || hipDeviceGetAttribute(&cus, hipDeviceAttributeMultiprocessorCount, dev) != hipSuccess) { fprintf(stderr, "kernel_launch: hipGetDevice / hipDeviceGetAttribute failed\n"); grid = -1; return; }
        if (hipFuncSetAttribute((const void*)mk_fwd, hipFuncAttributeMaxDynamicSharedMemorySize, LDS_BYTES) != hipSuccess) { fprintf(stderr, "kernel_launch: hipFuncSetAttribute failed\n"); grid = -1; return; }
        if (hipOccupancyMaxActiveBlocksPerMultiprocessor(&per_cu, (const void*)mk_fwd, NWAVES * 64, LDS_BYTES) != hipSuccess || per_cu < 1) { fprintf(stderr, "kernel_launch: occupancy query reports %d workgroups per CU\n", per_cu); per_cu = 1; }
        (void)hipGetLastError();
        if (cus < 256) { fprintf(stderr, "kernel_launch: this kernel needs 256 CUs (one 256x256 tile / one 64-token mixer chunk per workgroup); device has %d\n", cus); grid = -1; return; }
        grid = 256;
    }
    if (grid < 0) return;
    if (hipMemsetAsync((char*)d_ws + WS_CTL, 0, CTL_ZERO_BYTES, stream) != hipSuccess) { fprintf(stderr, "kernel_launch: hipMemsetAsync failed\n"); return; }
    Args a{};
    for (int i = 0; i < 23; ++i) a.in[i] = (const float*)d_in[i];
    a.out = (float*)d_out; a.ws = (unsigned char*)d_ws;
    for (int li = 0; li < N_LAUNCHES; ++li) {
        a.ph_lo = (N_LAUNCHES == PER_PHASE) ? li : 0; a.ph_hi = (N_LAUNCHES == PER_PHASE) ? li + 1 : PER_PHASE;
        hipLaunchKernelGGL(mk_fwd, dim3(grid), dim3(NWAVES * 64), LDS_BYTES, stream, a);
        const hipError_t le = hipPeekAtLastError();
        if (le != hipSuccess) { fprintf(stderr, "kernel_launch: launch %d failed: %s\n", li, hipGetErrorName(le)); break; }
    }
}
```

```cpp
#include <hip/hip_runtime.h>
#include <cstdio>
#include <cstdint>
namespace pg8 {
#define PG8_LAS __attribute__((address_space(3)))
typedef unsigned short bf16_t;
typedef short bf16x8 __attribute__((ext_vector_type(8)));
typedef float f32x4 __attribute__((ext_vector_type(4)));
typedef unsigned u32x4 __attribute__((ext_vector_type(4)));
constexpr int BM = 256, BK = 64, HALF = 128, HTB = HALF * BK * 2  , STAGE_BYTES = 8 * HTB, NXCD = 8, WGM = 8;

__host__ __device__ __forceinline__ int lds_byte(int r, int c) { const int st = (r >> 4) * 2 + (c >> 5), rr = r & 15, cc = c & 31, ob = rr * 64 + cc * 2; return st * 1024 + (ob ^ (((ob >> 9) & 1) << 5)); }
__host__ __device__ __forceinline__ void stage_rc(int b, int& R, int& C) { const int st = b / 1024, sb = b % 1024, swz = sb ^ (((sb >> 9) & 1) << 5); R = (st >> 1) * 16 + swz / 64; C = (st & 1) * 32 + (swz % 64) / 2; }
__host__ __device__ __forceinline__ int perm32(int rho) { const int n = rho >> 4, i = rho & 15; return 8 * (i >> 2) + 4 * n + (i & 3); }

struct Unit { int pm, pn; };
struct Gemm { const bf16_t* A; const bf16_t* Bt; int M, N, K; };

struct StaticOrder {
    int nM, nN, nwg, G, c;
    __host__ __device__ void init(int M, int N, int G_, int c_) { nM = M / BM; nN = N / BM; nwg = nM * nN; G = G_; c = c_; }
    __host__ __device__ bool next(int i, Unit& u) const {
        const long L = (long)i * G + c; if (L >= nwg) return false;
        int wgid = (int)L; { const int q = nwg / NXCD, r = nwg % NXCD, xcd = wgid % NXCD, off = wgid / NXCD; wgid = (xcd < r ? xcd * (q + 1) : r * (q + 1) + (xcd - r) * q) + off; }
        const int nig = WGM * nN, gid = wgid / nig, fm = gid * WGM, gsz = (nM - fm) < WGM ? (nM - fm) : WGM;
        u.pm = fm + ((wgid % nig) % gsz); u.pn = (wgid % nig) / gsz; return true;
    }
    __device__ __forceinline__ void a_ready(const Unit&) const {}
    __device__ __forceinline__ void done(const Unit&) const {}
};

__device__ __forceinline__ unsigned cvt_pk_bf16(float lo, float hi) { unsigned r; asm volatile("v_cvt_pk_bf16_f32 %0, %1, %2" : "=v"(r) : "v"(lo), "v"(hi)); return r; }
typedef float f32x2 __attribute__((ext_vector_type(2)));
__device__ __forceinline__ f32x2 gelu_pk(f32x2 v) {
    const f32x2 av = __builtin_elementwise_abs(v), d = av * 0.2316418882f + 1.0f;
    f32x2 t; t.x = __builtin_amdgcn_rcpf(d.x); t.y = __builtin_amdgcn_rcpf(d.y);
    f32x2 q = t * 0.5307027145f + (-0.7265760135f); q = q * t + 0.7107068705f; q = q * t + (-0.142248368f); q = q * t + 0.127414796f; q = q * t;
    const f32x2 s = (v * v) * (-0.72134752044f);
    f32x2 e; e.x = __builtin_amdgcn_exp2f(s.x); e.y = __builtin_amdgcn_exp2f(s.y);
    const f32x2 m = v * (q * e), r = v - m;
    f32x2 o; o.x = v.x < 0.f ? m.x : r.x; o.y = v.y < 0.f ? m.y : r.y; return o;
}

template <int ACT  > struct EpiBf16 {
    static constexpr bool PERM = true, AFTER_DRAIN = false; static_assert(ACT == 0 || ACT == 1, "EpiBf16: ACT is 0 (none) or 1 (gelu_pk)");
    bf16_t* O; int ldc; const float* bias; int split_cols; size_t split_stride; float scale0;
    __device__ __forceinline__ void operator()(const f32x4 (&acc)[2][2][4][2], const Unit& u, int wr, int wc, int fr, int fq) const {
        const int row0 = u.pm * BM + wr * 64 + fr; int colt = u.pn * BM; bf16_t* base = O;
        float sc = 1.f; if (split_cols) { const int t = colt / split_cols; base += (size_t)t * split_stride; colt -= t * split_cols; if (t == 0) sc = scale0; }
        const int col0 = colt + wc * 32 + 8 * fq, bcol0 = u.pn * BM + wc * 32 + 8 * fq;
        f32x4 bv[2][2];
#pragma unroll
        for (int bj = 0; bj < 2; ++bj)
#pragma unroll
            for (int n = 0; n < 2; ++n) bv[bj][n] = bias ? *(const f32x4*)(bias + bcol0 + bj * HALF + 4 * n) : (f32x4){0.f, 0.f, 0.f, 0.f};
#pragma unroll
        for (int ai = 0; ai < 2; ++ai)
#pragma unroll
            for (int m = 0; m < 4; ++m) { bf16_t* rowp = base + (size_t)(row0 + ai * HALF + m * 16) * ldc + col0;
#pragma unroll
                for (int bj = 0; bj < 2; ++bj) { f32x4 v0 = acc[ai][bj][m][0] + bv[bj][0], v1 = acc[ai][bj][m][1] + bv[bj][1];
                    if (ACT == 1) { f32x2 a = gelu_pk((f32x2){v0[0], v0[1]}), b = gelu_pk((f32x2){v0[2], v0[3]}), c = gelu_pk((f32x2){v1[0], v1[1]}), d = gelu_pk((f32x2){v1[2], v1[3]});
                        v0 = (f32x4){a.x, a.y, b.x, b.y}; v1 = (f32x4){c.x, c.y, d.x, d.y}; }
                    v0 = v0 * sc; v1 = v1 * sc; u32x4 w; w.x = cvt_pk_bf16(v0[0], v0[1]); w.y = cvt_pk_bf16(v0[2], v0[3]); w.z = cvt_pk_bf16(v1[0], v1[1]); w.w = cvt_pk_bf16(v1[2], v1[3]);
                    *(u32x4*)(rowp + bj * HALF) = w; } }
    }
};

constexpr float RMS_EPS_F = 1e-6f;
typedef unsigned u32x2 __attribute__((ext_vector_type(2)));
struct EpiUp {
    static constexpr bool PERM = true, AFTER_DRAIN = false;
    bf16_t* O; int ldc; const float* ss;
    __device__ __forceinline__ void operator()(const f32x4 (&acc)[2][2][4][2], const Unit& u, int wr, int wc, int fr, int fq) const {
        const int row0 = u.pm * BM + wr * 64 + fr; const int col0 = u.pn * BM + wc * 32 + 8 * fq;
#pragma unroll
        for (int ai = 0; ai < 2; ++ai)
#pragma unroll
            for (int m = 0; m < 4; ++m) { const int row = row0 + ai * HALF + m * 16; const f32x4 s4 = *(const f32x4*)(ss + (size_t)row * 4);
                const float rstd = __builtin_amdgcn_rsqf(((s4[0] + s4[1]) + (s4[2] + s4[3])) * (1.0f / 1024.0f) + RMS_EPS_F);
                bf16_t* rowp = O + (size_t)row * ldc + col0;
#pragma unroll
                for (int bj = 0; bj < 2; ++bj) { f32x4 v0 = acc[ai][bj][m][0] * rstd, v1 = acc[ai][bj][m][1] * rstd;
#pragma unroll
                    for (int j = 0; j < 4; ++j) { const float a = fmaxf(v0[j], 0.f), b = fmaxf(v1[j], 0.f); v0[j] = a * a; v1[j] = b * b; }
                    u32x4 w; w.x = cvt_pk_bf16(v0[0], v0[1]); w.y = cvt_pk_bf16(v0[2], v0[3]); w.z = cvt_pk_bf16(v1[0], v1[1]); w.w = cvt_pk_bf16(v1[2], v1[3]);
                    *(u32x4*)(rowp + bj * HALF) = w; } }
    }
};
struct EpiRes {
    static constexpr bool PERM = false, AFTER_DRAIN = true;
    const float* base; float* out; bf16_t* xn; float* ss;
    __device__ __forceinline__ void fused(f32x4 (&acc)[2][2][4][2], const Unit& u, int wr, int wc, int fr, int fq, PG8_LAS unsigned char* lds, int wid, int lane) const {
        PG8_LAS float* P = (PG8_LAS float*)lds;
        const int col0 = u.pn * BM + wc * 32 + 4 * fq;
#pragma unroll
        for (int ai = 0; ai < 2; ++ai)
#pragma unroll
            for (int m = 0; m < 4; ++m) { const int r = ai * HALF + wr * 64 + m * 16 + fr; const size_t off = (size_t)(u.pm * BM + r) * 1024 + col0; float s = 0.f;
#pragma unroll
                for (int bj = 0; bj < 2; ++bj)
#pragma unroll
                    for (int n = 0; n < 2; ++n) { const f32x4 bs = *(const f32x4*)(base + off + bj * HALF + n * 16); const f32x4 hv = bs + acc[ai][bj][m][n];
                        *(f32x4*)(out + off + bj * HALF + n * 16) = hv; s += (hv[0] * hv[0] + hv[1] * hv[1]) + (hv[2] * hv[2] + hv[3] * hv[3]);
                        u32x2 w; w.x = cvt_pk_bf16(hv[0], hv[1]); w.y = cvt_pk_bf16(hv[2], hv[3]); *(u32x2*)(xn + off + bj * HALF + n * 16) = w; }
                s += __shfl_xor(s, 16); s += __shfl_xor(s, 32);
                if (fq == 0) P[r * 4 + wc] = s;
                if (m & 1) asm volatile("" ::: "memory"); }
        asm volatile("s_waitcnt lgkmcnt(0)" ::: "memory"); __builtin_amdgcn_s_barrier(); asm volatile("" ::: "memory");
        const int t = wid * 64 + lane;
        if (t < 256) { const PG8_LAS f32x4* P4 = (const PG8_LAS f32x4*)lds; const f32x4 p = P4[t]; ss[(size_t)(u.pm * BM + t) * 4 + u.pn] = (p[0] + p[1]) + (p[2] + p[3]); }
    }
};
struct EpiGate {
    static constexpr bool PERM = false, AFTER_DRAIN = true;
    float* hio; const bf16_t* pp; const float* bg; const float* ss;
    __device__ __forceinline__ void fused(f32x4 (&acc)[2][2][4][2], const Unit& u, int wr, int wc, int fr, int fq, PG8_LAS unsigned char* lds, int wid, int lane) const {
        const int col0 = u.pn * BM + wc * 32 + 4 * fq;
        f32x4 bv[2][2];
#pragma unroll
        for (int bj = 0; bj < 2; ++bj)
#pragma unroll
            for (int n = 0; n < 2; ++n) bv[bj][n] = *(const f32x4*)(bg + col0 + bj * HALF + n * 16);
#pragma unroll
        for (int ai = 0; ai < 2; ++ai)
#pragma unroll
            for (int m = 0; m < 4; ++m) { const int row = u.pm * BM + ai * HALF + wr * 64 + m * 16 + fr; const size_t off = (size_t)row * 1024 + col0;
                const f32x4 s4 = *(const f32x4*)(ss + (size_t)row * 4);
                const float rstd = __builtin_amdgcn_rsqf(((s4[0] + s4[1]) + (s4[2] + s4[3])) * (1.0f / 1024.0f) + RMS_EPS_F);
#pragma unroll
                for (int bj = 0; bj < 2; ++bj)
#pragma unroll
                    for (int n = 0; n < 2; ++n) { const f32x4 z = acc[ai][bj][m][n] * rstd + bv[bj][n]; const u32x2 pw = *(const u32x2*)(pp + off + bj * HALF + n * 16);
                        const f32x4 h2 = *(const f32x4*)(hio + off + bj * HALF + n * 16);
                        f32x4 pv; pv[0] = __uint_as_float(pw.x << 16); pv[1] = __uint_as_float(pw.x & 0xffff0000u); pv[2] = __uint_as_float(pw.y << 16); pv[3] = __uint_as_float(pw.y & 0xffff0000u);
                        f32x4 o;
#pragma unroll
                        for (int j = 0; j < 4; ++j) { const float g = __builtin_amdgcn_rcpf(1.0f + __expf(-z[j])); o[j] = h2[j] + g * pv[j]; }
                        *(f32x4*)(hio + off + bj * HALF + n * 16) = o; }
                if (m & 1) asm volatile("" ::: "memory"); }
    }
};
template <class Epi, class Sched, bool ALIGN_EPI = false, bool SP2 = false>
__device__ __forceinline__ void gemm_phase(PG8_LAS unsigned char* lds, const Gemm g, const Sched& S, const Epi& E) {
    const int tid = threadIdx.x, wid = __builtin_amdgcn_readfirstlane(tid >> 6), lane = tid & 63, wr = wid >> 2, wc = wid & 3, fr = lane & 15, fq = lane >> 4;
    const int K = g.K, nt = K / BK;
    unsigned voffA[2], voffB[2];
#pragma unroll
    for (int i = 0; i < 2; ++i) { int R, C; stage_rc(tid * 16 + i * 8192, R, C); const int Rb = Epi::PERM ? ((R & ~31) + perm32(R & 31)) : R;
        voffA[i] = (unsigned)(R * K + C) * 2u; voffB[i] = (unsigned)(Rb * K + C) * 2u; }
    const size_t kstep = (size_t)(BK * 2);
    const size_t hstep = (size_t)HALF * K * 2;
    const size_t tstep = 2 * hstep;
    const unsigned ldsw = (unsigned)wid * 1024u;
    const int aoff = lds_byte(wr * 64 + fr, fq * 8), boff = lds_byte(wc * 32 + fr, fq * 8);
#define PG8_SA(b, h) (((b) * 2 + (h)) * HTB)
#define PG8_SB(b, h) ((4 + (b) * 2 + (h)) * HTB)
#define PG8_STAGE(bufoff, gbase, voff) do { _Pragma("unroll") for (int _i = 0; _i < 2; ++_i) \
        __builtin_amdgcn_global_load_lds((const unsigned*)((const char*)(gbase) + (voff)[_i]), (PG8_LAS unsigned*)(lds + (bufoff) + ldsw + _i * 8192), 16, 0, 0); } while (0)
#define PG8_LDA(dst, b, h) do { _Pragma("unroll") for (int m = 0; m < 4; ++m) _Pragma("unroll") for (int k = 0; k < 2; ++k) dst[m][k] = *(const PG8_LAS bf16x8*)(lds + PG8_SA(b, h) + aoff + m * 2048 + k * 1024); } while (0)
#define PG8_LDB(dst, b, h) do { _Pragma("unroll") for (int n = 0; n < 2; ++n) _Pragma("unroll") for (int k = 0; k < 2; ++k) dst[n][k] = *(const PG8_LAS bf16x8*)(lds + PG8_SB(b, h) + boff + n * 2048 + k * 1024); } while (0)
#define PG8_MMA(ai, bj, At, Bt) do { __builtin_amdgcn_s_setprio(1); _Pragma("unroll") for (int m = 0; m < 4; ++m) _Pragma("unroll") for (int n = 0; n < 2; ++n) _Pragma("unroll") for (int k = 0; k < 2; ++k) \
        acc[ai][bj][m][n] = __builtin_amdgcn_mfma_f32_16x16x32_bf16(Bt[n][k], At[m][k], acc[ai][bj][m][n], 0, 0, 0); __builtin_amdgcn_s_setprio(0); } while (0)
#define PG8_WAIT_V(n) asm volatile("s_waitcnt vmcnt(" #n ")" ::: "memory")
#define PG8_WAIT_L(n) asm volatile("s_waitcnt lgkmcnt(" #n ")" ::: "memory")
#define PG8_BAR __builtin_amdgcn_s_barrier()
#define PG8_SCHED __builtin_amdgcn_sched_barrier(0)
    Unit cur, nxt; int ui = 0;
    if (!S.next(0, cur)) return;
    f32x4 acc[2][2][4][2];
#pragma unroll
    for (int a = 0; a < 2; ++a)
#pragma unroll
        for (int b = 0; b < 2; ++b)
#pragma unroll
            for (int m = 0; m < 4; ++m)
#pragma unroll
                for (int n = 0; n < 2; ++n) acc[a][b][m][n] = (f32x4){0.f, 0.f, 0.f, 0.f};
    bf16x8 At[4][2], B0[2][2], B1[2][2];
    const char* cA = (const char*)g.A + (size_t)cur.pm * tstep; const char* cB = (const char*)g.Bt + (size_t)cur.pn * tstep;
    S.a_ready(cur);
    if constexpr (SP2) {
        PG8_STAGE(PG8_SB(0, 0), cB, voffB); PG8_STAGE(PG8_SB(0, 1), cB + hstep, voffB); PG8_STAGE(PG8_SA(0, 0), cA, voffA); PG8_STAGE(PG8_SA(0, 1), cA + hstep, voffA);
        if (wr == 1) PG8_BAR;
        PG8_WAIT_V(2); PG8_BAR;
        PG8_STAGE(PG8_SB(1, 0), cB + kstep, voffB); PG8_STAGE(PG8_SA(1, 0), cA + kstep, voffA); PG8_STAGE(PG8_SB(1, 1), cB + hstep + kstep, voffB);
        PG8_WAIT_V(6); PG8_BAR;
    } else {
        PG8_STAGE(PG8_SB(0, 0), cB, voffB); PG8_STAGE(PG8_SA(0, 0), cA, voffA); PG8_STAGE(PG8_SB(0, 1), cB + hstep, voffB); PG8_STAGE(PG8_SA(0, 1), cA + hstep, voffA);
        if (wr == 1) PG8_BAR;
        PG8_WAIT_V(4); PG8_BAR;
        PG8_STAGE(PG8_SB(1, 0), cB + kstep, voffB); PG8_STAGE(PG8_SA(1, 0), cA + kstep, voffA); PG8_STAGE(PG8_SB(1, 1), cB + hstep + kstep, voffB);
        PG8_WAIT_V(6); PG8_BAR;
    }
    for (;;) {
        const bool has_next = S.next(ui + 1, nxt);
        const char* nA = has_next ? (const char*)g.A + (size_t)nxt.pm * tstep : cA; const char* nB = has_next ? (const char*)g.Bt + (size_t)nxt.pn * tstep : cB;
        for (int t = 0; t < nt; t += 2) {
            const bool last = (t == nt - 2);
            const char* a1 = cA + (size_t)(t + 1) * kstep;
            const char* a2 = last ? nA : cA + (size_t)(t + 2) * kstep; const char* b2 = last ? nB : cB + (size_t)(t + 2) * kstep;
            const char* a3 = a2 + kstep; const char* b3 = b2 + kstep;
            if (last && has_next) S.a_ready(nxt);
            if constexpr (SP2) {
            PG8_LDB(B0, 0, 0); PG8_LDB(B1, 0, 1); PG8_SCHED; PG8_LDA(At, 0, 0); PG8_STAGE(PG8_SA(1, 1), a1 + hstep, voffA);
            PG8_WAIT_V(8); PG8_WAIT_L(0); PG8_BAR; PG8_MMA(0, 0, At, B0); PG8_MMA(0, 1, At, B1); PG8_BAR; PG8_SCHED;
            PG8_LDA(At, 0, 1); PG8_STAGE(PG8_SB(0, 0), b2, voffB); PG8_STAGE(PG8_SB(0, 1), b2 + hstep, voffB); PG8_STAGE(PG8_SA(0, 0), a2, voffA);
            PG8_WAIT_V(8); PG8_WAIT_L(0); PG8_BAR; PG8_MMA(1, 0, At, B0); PG8_MMA(1, 1, At, B1); PG8_BAR; PG8_SCHED;
            PG8_LDB(B0, 1, 0); PG8_LDB(B1, 1, 1); PG8_SCHED; PG8_LDA(At, 1, 0); PG8_STAGE(PG8_SA(0, 1), a2 + hstep, voffA);
            PG8_WAIT_V(8); PG8_WAIT_L(0); PG8_BAR; PG8_MMA(0, 0, At, B0); PG8_MMA(0, 1, At, B1); PG8_BAR; PG8_SCHED;
            PG8_LDA(At, 1, 1); PG8_STAGE(PG8_SB(1, 0), b3, voffB); PG8_STAGE(PG8_SB(1, 1), b3 + hstep, voffB); PG8_STAGE(PG8_SA(1, 0), a3, voffA);
            PG8_WAIT_V(8); PG8_WAIT_L(0); PG8_BAR; PG8_MMA(1, 0, At, B0); PG8_MMA(1, 1, At, B1); PG8_BAR; PG8_SCHED;
            } else {
            PG8_LDB(B0, 0, 0); PG8_SCHED; PG8_LDA(At, 0, 0); PG8_STAGE(PG8_SA(1, 1), a1 + hstep, voffA);
            PG8_WAIT_L(8); PG8_BAR; PG8_WAIT_L(0); PG8_MMA(0, 0, At, B0); PG8_BAR; PG8_SCHED;
            PG8_LDB(B1, 0, 1); PG8_STAGE(PG8_SB(0, 0), b2, voffB);
            PG8_BAR; PG8_WAIT_L(0); PG8_MMA(0, 1, At, B1); PG8_BAR;
            PG8_LDA(At, 0, 1); PG8_STAGE(PG8_SA(0, 0), a2, voffA);
            PG8_BAR; PG8_WAIT_L(0); PG8_MMA(1, 0, At, B0); PG8_BAR; PG8_SCHED;
            PG8_STAGE(PG8_SB(0, 1), b2 + hstep, voffB);
            PG8_WAIT_V(6); PG8_BAR; PG8_MMA(1, 1, At, B1); PG8_BAR;
            PG8_LDB(B0, 1, 0); PG8_SCHED; PG8_LDA(At, 1, 0); PG8_STAGE(PG8_SA(0, 1), a2 + hstep, voffA);
            PG8_WAIT_L(8); PG8_BAR; PG8_WAIT_L(0); PG8_MMA(0, 0, At, B0); PG8_BAR; PG8_SCHED;
            PG8_LDB(B1, 1, 1); PG8_STAGE(PG8_SB(1, 0), b3, voffB);
            PG8_BAR; PG8_WAIT_L(0); PG8_MMA(0, 1, At, B1); PG8_BAR;
            PG8_LDA(At, 1, 1); PG8_STAGE(PG8_SA(1, 0), a3, voffA);
            PG8_BAR; PG8_WAIT_L(0); PG8_MMA(1, 0, At, B0); PG8_BAR; PG8_SCHED;
            PG8_STAGE(PG8_SB(1, 1), b3 + hstep, voffB);
            PG8_WAIT_V(6); PG8_BAR; PG8_MMA(1, 1, At, B1); PG8_BAR;
            }
        }
        if constexpr (ALIGN_EPI) { if (wr == 0) PG8_BAR; }
        if constexpr (!Epi::AFTER_DRAIN) { E(acc, cur, wr, wc, fr, fq); S.done(cur); }
        if (!has_next) break;
#pragma unroll
        for (int a = 0; a < 2; ++a)
#pragma unroll
            for (int b = 0; b < 2; ++b)
#pragma unroll
                for (int m = 0; m < 4; ++m)
#pragma unroll
                    for (int n = 0; n < 2; ++n) acc[a][b][m][n] = (f32x4){0.f, 0.f, 0.f, 0.f};
        cur = nxt; cA = nA; cB = nB; ++ui;
        if constexpr (ALIGN_EPI) { if (wr == 1) PG8_BAR; }
    }
    PG8_WAIT_V(0);
    if constexpr (!ALIGN_EPI) { if (wr == 0) PG8_BAR; }
    PG8_BAR;
    if constexpr (Epi::AFTER_DRAIN) { E.fused(acc, cur, wr, wc, fr, fq, lds, wid, lane); S.done(cur); }
#undef PG8_SA
#undef PG8_SB
#undef PG8_STAGE
#undef PG8_LDA
#undef PG8_LDB
#undef PG8_MMA
#undef PG8_WAIT_V
#undef PG8_WAIT_L
#undef PG8_BAR
#undef PG8_SCHED
}
}

#ifndef PG8_SP2
#define PG8_SP2 true
#endif
#ifndef PG8_ALIGN
#define PG8_ALIGN true
#endif

constexpr int NWAVES = 8;
#ifndef MK_N_LAUNCHES
#define MK_N_LAUNCHES 1
#endif
constexpr int PER_PHASE = 8;
constexpr int N_LAUNCHES = MK_N_LAUNCHES;
static_assert(N_LAUNCHES == 1, "one launch only: the mixer phase has a grid barrier inside");

constexpr int BATCH = 2, T = 8192, D = 1024, FF = 4096, DPOOL = 512, DLRU = 512, NPROJ = 1536, PLE = 256, NHEADS = 8, HB = 64;
constexpr int M = BATCH * T;
constexpr int TC = 64, NCH = T / TC;

constexpr size_t MiB = 1u << 20;
constexpr size_t WS_CTL = 0, CTL_ZERO_BYTES = 64 * 1024;
constexpr size_t WS_WIN = 1 * MiB, WS_WOUT = 4 * MiB, WS_WUP = 6 * MiB, WS_WDN = 14 * MiB, WS_WG = 22 * MiB, WS_WPP = 24 * MiB;
constexpr size_t WS_WGA = 24 * MiB + 512 * 1024, WS_WGX = WS_WGA + 64 * 1024;
constexpr size_t WS_SS1 = 25 * MiB, WS_SS2 = WS_SS1 + 256 * 1024;
constexpr size_t WS_AGG = 26 * MiB;
constexpr size_t WS_HMID = 32 * MiB;
constexpr size_t WS_PROJ = 32 * MiB, WS_Y = 80 * MiB;
constexpr size_t WS_XN = 160 * MiB;
constexpr size_t WS_PP = 192 * MiB;
constexpr size_t WS_PB = 224 * MiB;
constexpr size_t WS_END = 256 * MiB;
static_assert(WS_WPP + (size_t)D * PLE * 2 <= WS_WGA && WS_WGX + 64 * 1024 <= WS_SS1 && WS_SS2 + 256 * 1024 <= WS_AGG && WS_AGG + 1 * MiB <= WS_HMID, "d_ws map (small)");
static_assert(WS_PROJ + (size_t)M * NPROJ * 2 <= WS_Y && WS_Y + (size_t)M * D * 2 <= WS_XN && WS_HMID + (size_t)M * FF * 2 <= WS_XN && WS_XN + (size_t)M * D * 2 <= WS_PP && WS_PP + (size_t)M * D * 2 <= WS_PB && WS_PB + (size_t)M * PLE * 2 <= WS_END, "d_ws map");
constexpr int CW_TMO = 0, CW_CODE = 1;
constexpr int CW_BAR = 4096;

constexpr int RING_OFF = 0, RING_BYTES = 131072;
constexpr int LDSCTL_OFF = RING_BYTES, MISC_OFF = LDSCTL_OFF + 320;
constexpr int LDS_BYTES = 147456;
static_assert(MISC_OFF + 128 <= LDS_BYTES, "LDS map");
#define GAS __attribute__((address_space(1)))
#define LAS __attribute__((address_space(3)))
typedef unsigned short bf16;
typedef unsigned v4u __attribute__((ext_vector_type(4)));
typedef float f32x4 __attribute__((ext_vector_type(4)));
typedef short bf16x8 __attribute__((ext_vector_type(8)));
typedef GAS unsigned gu32;
typedef GAS unsigned long long gu64;
#define RLX_AGENT __ATOMIC_RELAXED, __HIP_MEMORY_SCOPE_AGENT
#define LDS_WAIT() asm volatile("s_waitcnt lgkmcnt(0)" ::: "memory")
#define VM_WAIT() asm volatile("s_waitcnt vmcnt(0)" ::: "memory")
__device__ __forceinline__ unsigned long long rt() { return __builtin_amdgcn_s_memrealtime(); }
__device__ __forceinline__ unsigned f2bf(float f) { unsigned u = __builtin_bit_cast(unsigned, f); return (u + 0x7fffu + ((u >> 16) & 1u)) >> 16; }
__device__ __forceinline__ unsigned pk2(float lo, float hi) { return f2bf(lo) | (f2bf(hi) << 16); }

#define XB_TMO      128
#define XB_XCNT(j)  (256  + 64 * (j))
#define XB_XSUB(j)  (1280 + 64 * (j))
#define XB_XGEN(j)  (2304 + 64 * (j))
#define XB_TOP      3328
#define XB_TOPGEN   3392
#define XCD_BAR_WORDS 3456
#define XB_SPIN_CAP (1u << 18)

__device__ __forceinline__ unsigned xb_ld(unsigned* p)              { return __hip_atomic_load(p, __ATOMIC_RELAXED, __HIP_MEMORY_SCOPE_AGENT); }
__device__ __forceinline__ unsigned xb_add(unsigned* p, unsigned v) { return __hip_atomic_fetch_add(p, v, __ATOMIC_RELAXED, __HIP_MEMORY_SCOPE_AGENT); }
__device__ __forceinline__ unsigned xb_xcc_id() { return (unsigned)__builtin_amdgcn_s_getreg((3 << 11) | 20) & 0xFu; }
#define XB_SPIN(cond, bar) do { unsigned _sp = 0; while (cond) { __builtin_amdgcn_s_sleep(1); \
    if ((++_sp & 255u) == 0u) { if (xb_ld(&(bar)[XB_TMO])) break; if (_sp > XB_SPIN_CAP) { atomicAdd(&(bar)[XB_TMO], 1u); break; } } } } while (0)

struct XcdBarrier {
    unsigned* bar; unsigned x;
    volatile LAS unsigned* st;
};

__device__ __forceinline__ XcdBarrier xcd_barrier_post(unsigned* bar, volatile LAS unsigned* st) {
    XcdBarrier b; b.bar = bar; b.x = xb_xcc_id(); b.st = st;
    if (threadIdx.x == 0) (void)xb_add(&bar[XB_XCNT(b.x)], 1u);
    return b;
}
__device__ __forceinline__ void xcd_barrier_complete(unsigned* bar, unsigned x, unsigned& nloc, unsigned& nx) {
    const unsigned G = gridDim.x * gridDim.y * gridDim.z;
    unsigned sum, cnt, mine, sp = 0u;
    for (;;) {
        sum = 0u; cnt = 0u; mine = 0u;
#pragma unroll
        for (unsigned j = 0; j < 16; ++j) { const unsigned c = xb_ld(&bar[XB_XCNT(j)]); sum += c; cnt += (c > 0u) ? 1u : 0u; mine = (j == x) ? c : mine; }
        if (sum == G) break;
        __builtin_amdgcn_s_sleep(1);
        if ((++sp & 255u) == 0u) { if (xb_ld(&bar[XB_TMO])) break; if (sp > XB_SPIN_CAP) { atomicAdd(&bar[XB_TMO], 1u); break; } }
    }
    nloc = mine > 0u ? mine : 1u; nx = cnt > 0u ? cnt : 1u;
}

__device__ __forceinline__ void xcd_barrier(const XcdBarrier& b) {
    asm volatile("s_waitcnt vmcnt(0)" ::: "memory");
    __syncthreads();
    if (threadIdx.x == 0) {
        unsigned* bar = b.bar;
        __builtin_amdgcn_s_waitcnt(0);
        unsigned nloc = b.st[0], nx = b.st[1];
        if (nloc == 0u) { xcd_barrier_complete(bar, b.x, nloc, nx); b.st[0] = nloc; b.st[1] = nx; }
        const unsigned old = xb_add(&bar[XB_XSUB(b.x)], 1u);
        const unsigned gen = old / nloc;
        if (old + 1u == (gen + 1u) * nloc) {
            __builtin_amdgcn_fence(__ATOMIC_RELEASE, "agent");
            asm volatile("s_waitcnt vmcnt(0)" ::: "memory");
            const unsigned og = xb_add(&bar[XB_TOP], 1u);
            const unsigned tg = og / nx;
            if (og + 1u == (tg + 1u) * nx) xb_add(&bar[XB_TOPGEN], 1u);
            else XB_SPIN(xb_ld(&bar[XB_TOPGEN]) == tg, bar);
            __builtin_amdgcn_fence(__ATOMIC_ACQUIRE, "agent");
            xb_add(&bar[XB_XGEN(b.x)], 1u);
            asm volatile("s_waitcnt vmcnt(0)" ::: "memory");
        } else {
            XB_SPIN(xb_ld(&bar[XB_XGEN(b.x)]) == gen, bar);
            __builtin_amdgcn_fence(__ATOMIC_ACQUIRE, "agent");
            asm volatile("s_waitcnt vmcnt(0)" ::: "memory");
        }
    }
    __syncthreads();
}

typedef float f32x2 __attribute__((ext_vector_type(2)));

struct Frame {
    LAS unsigned char* lds;
    volatile LAS unsigned* MISC;
    gu32* ctl;
    int tid, lane, wave;
    int vcu, G;
    const float *x, *p, *g_mix, *w_in, *pool_w, *pool_b, *pool_scale, *conv_w, *conv_b, *ga_w, *ga_b, *gx_w, *gx_b, *lru_L, *w_out, *g_mlp, *w_up, *w_down, *g_ple, *w_gate, *b_gate, *w_pp, *g_final;
    float* out;
    bf16 *Win_t, *Wout_t, *Wup_t, *Wdn_t, *Wg_t, *Wpp_t, *Wga_t, *Wgx_t;
    bf16 *PROJ, *Y, *HMID, *XN, *PP, *PB;
    float *SS1, *SS2, *AGG;
};

__device__ __forceinline__ float wave_sum(float v) {
#pragma unroll
    for (int o = 1; o < 64; o <<= 1) v += __shfl_xor(v, o);
    return v;
}
__device__ __forceinline__ float bflo(unsigned w) { return __uint_as_float(w << 16); }
__device__ __forceinline__ float bfhi(unsigned w) { return __uint_as_float(w & 0xffff0000u); }
__device__ __forceinline__ void p0_transpose_item(const float* W, int ldw, int ncols, const float* kscale, bf16* WT, int ldt, LAS float* scr, int item, int lane) {
    const int nblk = ncols / 32, kb = item / nblk, nb = item % nblk, k0 = 64 * kb, n0 = 32 * nb;
#pragma unroll 8
    for (int i = 0; i < 32; ++i) { const int kk = 2 * i + (lane >> 5); float v = W[(size_t)(k0 + kk) * ldw + n0 + (lane & 31)]; if (kscale) v *= kscale[k0 + kk]; scr[kk * 33 + (lane & 31)] = v; }
    LDS_WAIT(); asm volatile("" ::: "memory");
    const int c = lane & 7;
#pragma unroll
    for (int j = 0; j < 4; ++j) { const int n = (lane >> 3) + 8 * j; const LAS float* s = scr + (8 * c) * 33 + n;
        v4u o; o.x = pk2(s[0 * 33], s[1 * 33]); o.y = pk2(s[2 * 33], s[3 * 33]); o.z = pk2(s[4 * 33], s[5 * 33]); o.w = pk2(s[6 * 33], s[7 * 33]);
        *(GAS v4u*)(WT + (size_t)(n0 + n) * ldt + k0 + 8 * c) = o; }
    LDS_WAIT(); asm volatile("" ::: "memory");
}
__device__ __forceinline__ void p0_poolfold_item(const float* w_in, const float* pool_w, bf16* Win_t, int item, int lane) {
    const int kb = item >> 4, nb = item & 15, k0 = 8 * kb, n0 = 32 * nb, g = n0 >> 7, nl = (n0 & 127) + (lane & 31), kk2 = lane >> 5;
    float acc[4] = {0.f, 0.f, 0.f, 0.f};
    const float* pw = pool_w + (size_t)g * 16384 + nl;
    const float* wi = w_in + (size_t)(k0 + kk2) * NPROJ + 128 * g;
#pragma unroll 4
    for (int j4 = 0; j4 < 32; ++j4) {
        const float p0 = pw[(4 * j4 + 0) * 128], p1 = pw[(4 * j4 + 1) * 128], p2 = pw[(4 * j4 + 2) * 128], p3 = pw[(4 * j4 + 3) * 128];
#pragma unroll
        for (int i = 0; i < 4; ++i) { const f32x4 w = *(const f32x4*)(wi + (size_t)(2 * i) * NPROJ + 4 * j4); acc[i] += (w[0] * p0 + w[1] * p1) + (w[2] * p2 + w[3] * p3); }
    }
    float o[4];
#pragma unroll
    for (int i = 0; i < 4; ++i) o[i] = __shfl_xor(acc[i], 32);
    if (lane < 32) { v4u w; w.x = pk2(acc[0], o[0]); w.y = pk2(acc[1], o[1]); w.z = pk2(acc[2], o[2]); w.w = pk2(acc[3], o[3]);
        *(GAS v4u*)(Win_t + (size_t)(n0 + lane) * D + k0) = w; }
}
__device__ __forceinline__ void rms_row_to_bf16(const float* xrow, const float* g, bf16* orow, int lane) {
    const GAS f32x4* xr = (const GAS f32x4*)xrow + lane; const GAS f32x4* gr = (const GAS f32x4*)g + lane;
    f32x4 v[4]; float s = 0.f;
#pragma unroll
    for (int j = 0; j < 4; ++j) { v[j] = xr[64 * j]; s += (v[j][0] * v[j][0] + v[j][1] * v[j][1]) + (v[j][2] * v[j][2] + v[j][3] * v[j][3]); }
    const float rstd = 1.f / sqrtf(wave_sum(s) * (1.f / D) + 1e-6f);
    GAS unsigned long long* o8 = (GAS unsigned long long*)orow + lane;
#pragma unroll
    for (int j = 0; j < 4; ++j) { const f32x4 gg = gr[64 * j]; o8[64 * j] = (unsigned long long)pk2(v[j][0] * rstd * gg[0], v[j][1] * rstd * gg[1]) | ((unsigned long long)pk2(v[j][2] * rstd * gg[2], v[j][3] * rstd * gg[3]) << 32); }
}
__device__ __forceinline__ void rms_row_f32(float* row, const float* g, int lane) {
    GAS f32x4* xr = (GAS f32x4*)row + lane; const GAS f32x4* gr = (const GAS f32x4*)g + lane;
    f32x4 v[4]; float s = 0.f;
#pragma unroll
    for (int j = 0; j < 4; ++j) { v[j] = xr[64 * j]; s += (v[j][0] * v[j][0] + v[j][1] * v[j][1]) + (v[j][2] * v[j][2] + v[j][3] * v[j][3]); }
    const float rstd = 1.f / sqrtf(wave_sum(s) * (1.f / D) + 1e-6f);
#pragma unroll
    for (int j = 0; j < 4; ++j) { const f32x4 gg = gr[64 * j]; xr[64 * j] = (v[j] * rstd) * gg; }
}
__device__ __forceinline__ void p0_prologue(Frame& F) {
    LAS float* scr = (LAS float*)(F.lds + RING_OFF + F.wave * 16384);
    const int gw = F.vcu * NWAVES + F.wave, NGW = F.G * NWAVES;
    constexpr int I_IN = (D / 64) * (1024 / 32), I_OUT = (D / 64) * (D / 32), I_UP = (D / 64) * (FF / 32), I_DN = (FF / 64) * (D / 32), I_G = (D / 64) * (D / 32), I_PP = (PLE / 64) * (D / 32), I_GA = 16, I_GX = 16;
    constexpr int NT = I_IN + I_OUT + I_UP + I_DN + I_G + I_PP + I_GA + I_GX, I_FOLD = 2048;
    for (int it = gw; it < NT + I_FOLD; it += NGW) {
        int r = it;
        if (r < I_IN) { p0_transpose_item(F.w_in + 512, NPROJ, 1024, nullptr, F.Win_t + (size_t)512 * D, D, scr, r, F.lane); continue; } r -= I_IN;
        if (r < I_OUT) { p0_transpose_item(F.w_out, D, D, nullptr, F.Wout_t, D, scr, r, F.lane); continue; } r -= I_OUT;
        if (r < I_UP) { p0_transpose_item(F.w_up, FF, FF, F.g_mlp, F.Wup_t, D, scr, r, F.lane); continue; } r -= I_UP;
        if (r < I_DN) { p0_transpose_item(F.w_down, D, D, nullptr, F.Wdn_t, FF, scr, r, F.lane); continue; } r -= I_DN;
        if (r < I_G) { p0_transpose_item(F.w_gate, D, D, F.g_ple, F.Wg_t, D, scr, r, F.lane); continue; } r -= I_G;
        if (r < I_PP) { p0_transpose_item(F.w_pp, D, D, nullptr, F.Wpp_t, PLE, scr, r, F.lane); continue; } r -= I_PP;
        if (r < I_GA) { p0_transpose_item(F.ga_w + (size_t)(r >> 1) * 4096, 64, 64, nullptr, F.Wga_t + (size_t)(r >> 1) * 4096, 64, scr, r & 1, F.lane); continue; } r -= I_GA;
        if (r < I_GX) { p0_transpose_item(F.gx_w + (size_t)(r >> 1) * 4096, 64, 64, nullptr, F.Wgx_t + (size_t)(r >> 1) * 4096, 64, scr, r & 1, F.lane); continue; } r -= I_GX;
        p0_poolfold_item(F.w_in, F.pool_w, F.Win_t, r, F.lane);
    }
    for (int m = gw; m < M; m += NGW) {
        rms_row_to_bf16(F.x + (size_t)m * D, F.g_mix, F.XN + (size_t)m * D, F.lane);
        const f32x4 pv = *((const GAS f32x4*)(F.p + (size_t)m * PLE) + F.lane);
        *((GAS unsigned long long*)(F.PB + (size_t)m * PLE) + F.lane) = (unsigned long long)pk2(pv[0], pv[1]) | ((unsigned long long)pk2(pv[2], pv[3]) << 32);
    }
}

typedef float f32x16 __attribute__((ext_vector_type(16)));
template <class Tv> __device__ __forceinline__ Tv gld(const void* base, unsigned off) { return *(const GAS Tv*)((const GAS char*)base + off); }
__device__ __forceinline__ float sigmoidf_(float z) { return __builtin_amdgcn_rcpf(1.0f + __expf(-z)); }
__device__ __forceinline__ float gelu_tanh(float v) { const float y = 0.7978845608028654f * (v + 0.044715f * v * v * v); const float t = 1.0f - 2.0f * __builtin_amdgcn_rcpf(1.0f + __expf(2.0f * y)); return 0.5f * v * (1.0f + t); }
template <int W>
__device__ __forceinline__ void pool_wave(const bf16* vbase, bf16* ybase, int tb, int ch, float pb0, float pb1, float ps0, float ps1) {
    unsigned raw[W + 31];
#pragma unroll
    for (int i = 0; i < W + 31; ++i) { const int tt = tb - (W - 1) + i; const unsigned rv = *(const GAS unsigned*)(vbase + (size_t)(tt >= 0 ? tt : 0) * NPROJ + ch); raw[i] = (tt >= 0) ? rv : 0u; }
    float s0 = 0.f, s1 = 0.f;
#pragma unroll
    for (int i = 0; i < W - 1; ++i) { s0 += bflo(raw[i]); s1 += bfhi(raw[i]); }
#pragma unroll
    for (int o = 0; o < 32; ++o) {
        const float c0 = bflo(raw[o + W - 1]), c1 = bfhi(raw[o + W - 1]); s0 += c0; s1 += c1;
        const int tt = tb + o; const float inv = 1.0f / (float)((tt + 1 < W) ? (tt + 1) : W);
        const float y0 = ((s0 * inv - c0) + pb0) * ps0, y1 = ((s1 * inv - c1) + pb1) * ps1;
        *(GAS unsigned*)(ybase + (size_t)tt * D + ch) = pk2(y0, y1);
        s0 -= bflo(raw[o]); s1 -= bfhi(raw[o]);
    }
}
constexpr int MX_U = 0, MX_X = 9728, MX_WAVE = 14336, MX_EXCH = 8 * MX_WAVE, USTR = 144, NCK = T / 256;
static_assert(MX_EXCH + 4096 + 8192 <= RING_BYTES && 67 * USTR <= MX_X && MX_X + 32 * USTR <= MX_WAVE, "mixer LDS map");
__device__ __forceinline__ void mixer_phase(Frame& F, const XcdBarrier& bar) {
    const int lane = F.lane, l31 = lane & 31, hh = lane >> 5, w = F.wave;
    const int unit = blockIdx.x, b = unit >> 7, hp = (unit >> 5) & 3, c = unit & 31, t0 = c * 256;
    const bf16* projb = F.PROJ + (size_t)b * T * NPROJ; bf16* yb = F.Y + (size_t)b * T * D;
    {
        const int ch = 128 * hp + 2 * lane, tb = t0 + 32 * w;
        const float pb0 = F.pool_b[ch], pb1 = F.pool_b[ch + 1], ps0 = F.pool_scale[ch], ps1 = F.pool_scale[ch + 1];
        if (hp == 0) pool_wave<2>(projb, yb, tb, ch, pb0, pb1, ps0, ps1);
        else if (hp == 1) pool_wave<4>(projb, yb, tb, ch, pb0, pb1, ps0, ps1);
        else if (hp == 2) pool_wave<8>(projb, yb, tb, ch, pb0, pb1, ps0, ps1);
        else pool_wave<16>(projb, yb, tb, ch, pb0, pb1, ps0, ps1);
    }
    asm volatile("" ::: "memory"); __builtin_amdgcn_sched_barrier(0);
    const int hl = w >> 2, qtr = w & 3, h = 2 * hp + hl, tq = t0 + 64 * qtr;
    LAS unsigned char* U = F.lds + RING_OFF + w * MX_WAVE + MX_U; LAS unsigned char* X = F.lds + RING_OFF + w * MX_WAVE + MX_X;
    const int rr = lane >> 3, ck = lane & 7;
    {
        const char* pju = (const char*)(projb + DPOOL + 64 * h);
        v4u ur[9];
#pragma unroll
        for (int i = 0; i < 9; ++i) { const int r = rr + 8 * i, tok = tq - 3 + (r < 67 ? r : 66); ur[i] = gld<v4u>(pju, (unsigned)(tok >= 0 ? tok : 0) * (NPROJ * 2u) + (unsigned)ck * 16u); if (tok < 0) ur[i] = (v4u){0u, 0u, 0u, 0u}; }
#pragma unroll
        for (int i = 0; i < 9; ++i) { const int r = rr + 8 * i; if (r < 67) *(LAS v4u*)(U + r * USTR + ck * 16) = ur[i]; }
    }
    float cw[2][4], cbias[2], ba[2], bx[2], cL[2];
    { const unsigned lc4 = (unsigned)l31 * 4u; const char* cwb = (const char*)(F.conv_w + 64 * h); const char* cbb = (const char*)(F.conv_b + 64 * h);
      const char* gab = (const char*)(F.ga_b + 64 * h); const char* gxb = (const char*)(F.gx_b + 64 * h); const char* lL = (const char*)(F.lru_L + 64 * h);
#pragma unroll
      for (int cb = 0; cb < 2; ++cb) {
#pragma unroll
          for (int k = 0; k < 4; ++k) cw[cb][k] = gld<float>(cwb, lc4 + 128u * cb + 2048u * k);
          cbias[cb] = gld<float>(cbb, lc4 + 128u * cb); ba[cb] = gld<float>(gab, lc4 + 128u * cb); bx[cb] = gld<float>(gxb, lc4 + 128u * cb);
          cL[cb] = -8.0f * log1pf(__expf(-gld<float>(lL, lc4 + 128u * cb))); } }
    const char* wga = (const char*)(F.Wga_t + (size_t)h * 4096); const char* wgx = (const char*)(F.Wgx_t + (size_t)h * 4096);
    const unsigned lane_w = (unsigned)(l31 * 64 + 8 * hh) * 2u;
    const char* pjg = (const char*)(projb + (size_t)tq * NPROJ + DPOOL + DLRU + 64 * h);
    char* yrow = (char*)(yb + (size_t)tq * D + DPOOL + 64 * h);
    float sB[2] = {0.f, 0.f}, sA[2] = {1.f, 1.f}, pA[2] = {1.f, 1.f}, pB[2] = {0.f, 0.f};
#pragma unroll 1
    for (int pass = 0; pass < 2; ++pass) {
#pragma unroll 1
        for (int rb = 0; rb < 2; ++rb) {
            v4u ugr[4];
            if (pass == 1) {
#pragma unroll
                for (int i = 0; i < 4; ++i) ugr[i] = gld<v4u>(pjg, (unsigned)(32 * rb + rr + 8 * i) * (NPROJ * 2u) + (unsigned)ck * 16u); }
            float xbc[2][16];
#pragma unroll
            for (int cb = 0; cb < 2; ++cb) {
                const LAS unsigned char* up = U + (32 * rb + 4 * hh) * USTR + (32 * cb + l31) * 2;
#pragma unroll
                for (int q = 0; q < 4; ++q) {
                    float uv[7];
#pragma unroll
                    for (int j = 0; j < 7; ++j) uv[j] = __uint_as_float((unsigned)(*(const LAS unsigned short*)(up + (8 * q + j) * USTR)) << 16);
#pragma unroll
                    for (int i = 0; i < 4; ++i) { const float v = cbias[cb] + ((cw[cb][0] * uv[i] + cw[cb][1] * uv[i + 1]) + (cw[cb][2] * uv[i + 2] + cw[cb][3] * uv[i + 3])); xbc[cb][4 * q + i] = v;
                        *(LAS unsigned short*)(X + (8 * q + 4 * hh + i) * USTR + (32 * cb + l31) * 2) = (unsigned short)f2bf(v); }
                }
            }
            bf16x8 Af[4];
#pragma unroll
            for (int ks = 0; ks < 4; ++ks) Af[ks] = *(const LAS bf16x8*)(X + l31 * USTR + (16 * ks + 8 * hh) * 2);
            if (pass == 1) {
#pragma unroll
                for (int i = 0; i < 4; ++i) *(LAS v4u*)(X + (rr + 8 * i) * USTR + ck * 16) = ugr[i]; }
#pragma unroll
            for (int cb = 0; cb < 2; ++cb) {
                f32x16 aR, aI;
#pragma unroll
                for (int e = 0; e < 16; ++e) { aR[e] = 0.f; aI[e] = 0.f; }
#pragma unroll
                for (int ks = 0; ks < 4; ++ks) {
                    const bf16x8 Ba = gld<bf16x8>(wga, lane_w + 4096u * cb + 32u * ks), Bx = gld<bf16x8>(wgx, lane_w + 4096u * cb + 32u * ks);
                    aR = __builtin_amdgcn_mfma_f32_32x32x16_bf16(Af[ks], Ba, aR, 0, 0, 0);
                    aI = __builtin_amdgcn_mfma_f32_32x32x16_bf16(Af[ks], Bx, aI, 0, 0, 0);
                }
                float av[16], bv[16];
#pragma unroll
                for (int e = 0; e < 16; ++e) {
                    const int tok = (e & 3) + 8 * (e >> 2) + 4 * hh;
                    const float r = sigmoidf_(aR[e] + ba[cb]), ig = sigmoidf_(aI[e] + bx[cb]);
                    const float a = __expf(cL[cb] * r); float mult = __builtin_amdgcn_sqrtf(fmaxf(1.0f - a * a, 0.f));
                    if (tq + 32 * rb + tok == 0) mult = 1.0f;
                    av[e] = a; bv[e] = mult * ig * xbc[cb][e];
                }
                float Aq[4], Bq[4], pAq[4], pBq[4];
#pragma unroll
                for (int q = 0; q < 4; ++q) { const float a0 = av[4 * q], a1 = av[4 * q + 1], a2 = av[4 * q + 2], a3 = av[4 * q + 3];
                    Aq[q] = (a0 * a1) * (a2 * a3); Bq[q] = ((bv[4 * q] * a1 + bv[4 * q + 1]) * a2 + bv[4 * q + 2]) * a3 + bv[4 * q + 3];
                    pAq[q] = __shfl_xor(Aq[q], 32); pBq[q] = __shfl_xor(Bq[q], 32); }
                float s = sB[cb], pa = sA[cb];
#pragma unroll
                for (int q = 0; q < 4; ++q) { const float A0 = hh ? pAq[q] : Aq[q], B0 = hh ? pBq[q] : Bq[q], A1 = hh ? Aq[q] : pAq[q], B1 = hh ? Bq[q] : pBq[q];
                    const float s0 = s, s1 = A0 * s0 + B0; s = A1 * s1 + B1; pa *= A0 * A1;
                    if (pass == 1) { float hp_ = hh ? s1 : s0;
#pragma unroll
                        for (int i = 0; i < 4; ++i) { const int e = 4 * q + i, tok = 8 * q + 4 * hh + i; hp_ = av[e] * hp_ + bv[e];
                            LAS unsigned short* xp = (LAS unsigned short*)(X + tok * USTR + (32 * cb + l31) * 2);
                            const float ug = __uint_as_float((unsigned)(*xp) << 16); *xp = (unsigned short)f2bf(hp_ * gelu_tanh(ug)); } } }
                sB[cb] = s; sA[cb] = pa;
            }
            if (pass == 1) {
#pragma unroll
                for (int i = 0; i < 4; ++i) { const int r = rr + 8 * i; const v4u v = *(const LAS v4u*)(X + r * USTR + ck * 16);
                    *(GAS v4u*)((GAS char*)yrow + (unsigned)(32 * rb + r) * (D * 2u) + (unsigned)ck * 16u) = v; } }
        }
        if (pass == 0) {
            LAS f32x2* EX = (LAS f32x2*)(F.lds + RING_OFF + MX_EXCH);
            if (hh == 0) {
#pragma unroll
                for (int cb = 0; cb < 2; ++cb) { f32x2 v; v[0] = sA[cb]; v[1] = sB[cb]; EX[w * 64 + 32 * cb + l31] = v; } }
            __syncthreads();
#pragma unroll
            for (int cb = 0; cb < 2; ++cb) {
#pragma unroll
                for (int qq = 0; qq < 3; ++qq) if (qq < qtr) { const f32x2 v = EX[(4 * hl + qq) * 64 + 32 * cb + l31]; pB[cb] = v[0] * pB[cb] + v[1]; pA[cb] *= v[0]; } }
            if (qtr == 3 && hh == 0) {
                char* agw = (char*)(F.AGG + ((size_t)(b * NCK + c) * DLRU + 64 * h) * 2);
#pragma unroll
                for (int cb = 0; cb < 2; ++cb) { f32x2 v; v[0] = sA[cb] * pA[cb]; v[1] = sA[cb] * pB[cb] + sB[cb]; *(GAS f32x2*)((GAS char*)agw + (unsigned)l31 * 8u + 256u * cb) = v; } }
            xcd_barrier(bar);
            const int sg = 2 * qtr + hh, lo_ = (c * sg) >> 3, hi_ = (c * (sg + 1)) >> 3;
            float A[2] = {1.f, 1.f}, B[2] = {0.f, 0.f};
            const char* ag = (const char*)(F.AGG + ((size_t)(b * NCK) * DLRU + 64 * h) * 2);
            unsigned ao = (unsigned)lo_ * (DLRU * 8u) + (unsigned)l31 * 8u;
#pragma unroll 4
            for (int cp = lo_; cp < hi_; ++cp, ao += DLRU * 8u) {
#pragma unroll
                for (int cb = 0; cb < 2; ++cb) { const f32x2 v = gld<f32x2>(ag, ao + 256u * cb); B[cb] = v[0] * B[cb] + v[1]; A[cb] *= v[0]; } }
            LAS f32x2* EX2 = (LAS f32x2*)(F.lds + RING_OFF + MX_EXCH + 4096);
#pragma unroll
            for (int cb = 0; cb < 2; ++cb) { f32x2 v; v[0] = A[cb]; v[1] = B[cb]; EX2[(hl * 8 + sg) * 64 + 32 * cb + l31] = v; }
            __syncthreads();
#pragma unroll
            for (int cb = 0; cb < 2; ++cb) { float cc = 0.f;
#pragma unroll
                for (int g8 = 0; g8 < 8; ++g8) { const f32x2 v = EX2[(hl * 8 + g8) * 64 + 32 * cb + l31]; cc = v[0] * cc + v[1]; }
                sB[cb] = pA[cb] * cc + pB[cb]; sA[cb] = 1.f; }
        }
    }
}

__device__ __forceinline__ void phase0(Frame& F) { p0_prologue(F); }
__device__ __forceinline__ void phase1(Frame& F) {
    { pg8::Gemm g{F.XN, F.Win_t, M, NPROJ, D}; pg8::StaticOrder S; S.init(M, NPROJ, F.G, (int)blockIdx.x);
      pg8::EpiBf16<0> E{F.PROJ, NPROJ, nullptr, 0, 0, 1.f};
      pg8::gemm_phase<pg8::EpiBf16<0>, pg8::StaticOrder, PG8_ALIGN, PG8_SP2>(F.lds + RING_OFF, g, S, E); }
    { pg8::Gemm g{F.PB, F.Wpp_t, M, D, PLE}; pg8::StaticOrder S; S.init(M, D, F.G, (int)blockIdx.x);
      pg8::EpiBf16<0> E{F.PP, D, nullptr, 0, 0, 1.f};
      pg8::gemm_phase<pg8::EpiBf16<0>, pg8::StaticOrder, PG8_ALIGN, PG8_SP2>(F.lds + RING_OFF, g, S, E); }
}
__device__ __forceinline__ void phase4(Frame& F) {
    pg8::Gemm g{F.Y, F.Wout_t, M, D, D}; pg8::StaticOrder S; S.init(M, D, F.G, (int)blockIdx.x);
    pg8::EpiRes E{F.x, F.out, F.XN, F.SS1};
    pg8::gemm_phase<pg8::EpiRes, pg8::StaticOrder, false, PG8_SP2>(F.lds + RING_OFF, g, S, E);
}
__device__ __forceinline__ void phase5(Frame& F) {
    pg8::Gemm g{F.XN, F.Wup_t, M, FF, D}; pg8::StaticOrder S; S.init(M, FF, F.G, (int)blockIdx.x);
    pg8::EpiUp E{F.HMID, FF, F.SS1};
    pg8::gemm_phase<pg8::EpiUp, pg8::StaticOrder, PG8_ALIGN, PG8_SP2>(F.lds + RING_OFF, g, S, E);
}
__device__ __forceinline__ void phase6(Frame& F) {
    pg8::Gemm g{F.HMID, F.Wdn_t, M, D, FF}; pg8::StaticOrder S; S.init(M, D, F.G, (int)blockIdx.x);
    pg8::EpiRes E{F.out, F.out, F.XN, F.SS2};
    pg8::gemm_phase<pg8::EpiRes, pg8::StaticOrder, false, PG8_SP2>(F.lds + RING_OFF, g, S, E);
}
__device__ __forceinline__ void phase7(Frame& F) {
    pg8::Gemm g{F.XN, F.Wg_t, M, D, D}; pg8::StaticOrder S; S.init(M, D, F.G, (int)blockIdx.x);
    pg8::EpiGate E{F.out, F.PP, F.b_gate, F.SS2};
    pg8::gemm_phase<pg8::EpiGate, pg8::StaticOrder, false, PG8_SP2>(F.lds + RING_OFF, g, S, E);
}
__device__ __forceinline__ void phase8(Frame& F) {
    const int gw = F.vcu * NWAVES + F.wave, NGW = F.G * NWAVES;
    for (int m = gw; m < M; m += NGW) rms_row_f32(F.out + (size_t)m * D, F.g_final, F.lane);
}

struct Args { const float* in[23]; float* out; unsigned char* ws; int ph_lo, ph_hi; };
__global__ void __launch_bounds__(NWAVES * 64, 2) mk_fwd(Args args) {
    extern __shared__ __attribute__((aligned(16))) unsigned char lds[];
    Frame F;
    F.lds = (LAS unsigned char*)lds;
    F.MISC = (volatile LAS unsigned*)(F.lds + MISC_OFF);
    F.tid = threadIdx.x; F.lane = F.tid & 63; F.wave = __builtin_amdgcn_readfirstlane(F.tid >> 6);
    F.G = gridDim.x; { const int bx = blockIdx.x; F.vcu = (F.G % 8 == 0) ? (bx % 8) * (F.G / 8) + bx / 8 : bx; }
    unsigned char* ws = args.ws;
    F.ctl = (gu32*)(ws + WS_CTL);
    F.x = args.in[0]; F.p = args.in[1]; F.g_mix = args.in[2]; F.w_in = args.in[3]; F.pool_w = args.in[4]; F.pool_b = args.in[5]; F.pool_scale = args.in[6]; F.conv_w = args.in[7]; F.conv_b = args.in[8];
    F.ga_w = args.in[9]; F.ga_b = args.in[10]; F.gx_w = args.in[11]; F.gx_b = args.in[12]; F.lru_L = args.in[13]; F.w_out = args.in[14]; F.g_mlp = args.in[15]; F.w_up = args.in[16]; F.w_down = args.in[17];
    F.g_ple = args.in[18]; F.w_gate = args.in[19]; F.b_gate = args.in[20]; F.w_pp = args.in[21]; F.g_final = args.in[22]; F.out = args.out;
    F.Win_t = (bf16*)(ws + WS_WIN); F.Wout_t = (bf16*)(ws + WS_WOUT); F.Wup_t = (bf16*)(ws + WS_WUP); F.Wdn_t = (bf16*)(ws + WS_WDN); F.Wg_t = (bf16*)(ws + WS_WG); F.Wpp_t = (bf16*)(ws + WS_WPP);
    F.Wga_t = (bf16*)(ws + WS_WGA); F.Wgx_t = (bf16*)(ws + WS_WGX);
    F.PROJ = (bf16*)(ws + WS_PROJ); F.Y = (bf16*)(ws + WS_Y); F.HMID = (bf16*)(ws + WS_HMID); F.XN = (bf16*)(ws + WS_XN); F.PP = (bf16*)(ws + WS_PP); F.PB = (bf16*)(ws + WS_PB);
    F.SS1 = (float*)(ws + WS_SS1); F.SS2 = (float*)(ws + WS_SS2); F.AGG = (float*)(ws + WS_AGG);
    for (int u = F.tid; u < (LDS_BYTES - LDSCTL_OFF) / 4; u += NWAVES * 64) ((LAS unsigned*)(F.lds + LDSCTL_OFF))[u] = 0u;
    __syncthreads();
    XcdBarrier bar; bar.bar = (unsigned*)(F.ctl + CW_BAR); bar.x = 0; bar.st = nullptr;
    if (N_LAUNCHES == 1) bar = xcd_barrier_post((unsigned*)(F.ctl + CW_BAR), F.MISC + 8);
    const int lo = args.ph_lo, hi = args.ph_hi;
#ifdef ONLY_PHASE
#define IN(k) ((k) == ONLY_PHASE && lo <= (k) && (k) < hi)
#else
#define IN(k) (lo <= (k) && (k) < hi)
#endif
#define SEAM(k) do { if (IN(k) && IN((k) + 1)) xcd_barrier(bar); } while (0)
#ifdef PROBE_DUP
#define DUP(k, call) do { if ((k) == PROBE_DUP) { asm volatile("" ::: "memory"); __syncthreads(); call; } } while (0)
#else
#define DUP(k, call) do { } while (0)
#endif

    if (IN(0)) { phase0(F); DUP(0, phase0(F)); } SEAM(0);
    if (IN(1)) { phase1(F); DUP(1, phase1(F)); } SEAM(1);
    if (IN(2)) { mixer_phase(F, bar); DUP(2, mixer_phase(F, bar)); } SEAM(2);
    if (IN(3)) { phase4(F); DUP(3, phase4(F)); } SEAM(3);
    if (IN(4)) { phase5(F); DUP(4, phase5(F)); } SEAM(4);
    if (IN(5)) { phase6(F); } SEAM(5);
    if (IN(6)) { phase7(F); } SEAM(6);
    if (IN(7)) { phase8(F); }
#undef IN
#undef SEAM
}

extern "C" void kernel_launch(void* const* d_in, const int* in_sizes, int n_in, void* d_out, int out_size, void* d_ws, size_t ws_size, hipStream_t stream) {
    static int grid = 0;
    if (grid == 0) {
        if (n_in != 23 || in_sizes[0] != M * D || out_size != M * D || ws_size < WS_END) { fprintf(stderr, "kernel_launch: unexpected shapes (n_in %d, in0 %d, out %d, ws %zu); nothing launched\n", n_in, n_in > 0 ? in_sizes[0] : -1, out_size, ws_size); grid = -1; return; }
        int dev = 0, cus = 0, per_cu = 0;
        if (hipGetDevice(&dev) != hipSuccess || hipDeviceGetAttribute(&cus, hipDeviceAttributeMultiprocessorCount, dev) != hipSuccess) { fprintf(stderr, "kernel_launch: hipGetDevice / hipDeviceGetAttribute failed\n"); grid = -1; return; }
        if (hipFuncSetAttribute((const void*)mk_fwd, hipFuncAttributeMaxDynamicSharedMemorySize, LDS_BYTES) != hipSuccess) { fprintf(stderr, "kernel_launch: hipFuncSetAttribute failed\n"); grid = -1; return; }
        if (hipOccupancyMaxActiveBlocksPerMultiprocessor(&per_cu, (const void*)mk_fwd, NWAVES * 64, LDS_BYTES) != hipSuccess || per_cu < 1) { fprintf(stderr, "kernel_launch: occupancy query reports %d workgroups per CU\n", per_cu); per_cu = 1; }
        (void)hipGetLastError();
        if (cus < 256) { fprintf(stderr, "kernel_launch: this kernel needs 256 CUs (one 256x256 tile / one 64-token mixer chunk per workgroup); device has %d\n", cus); grid = -1; return; }
        grid = 256;
    }
    if (grid < 0) return;
    if (hipMemsetAsync((char*)d_ws + WS_CTL, 0, CTL_ZERO_BYTES, stream) != hipSuccess) { fprintf(stderr, "kernel_launch: hipMemsetAsync failed\n"); return; }
    Args a{};
    for (int i = 0; i < 23; ++i) a.in[i] = (const float*)d_in[i];
    a.out = (float*)d_out; a.ws = (unsigned char*)d_ws;
    for (int li = 0; li < N_LAUNCHES; ++li) {
        a.ph_lo = (N_LAUNCHES == PER_PHASE) ? li : 0; a.ph_hi = (N_LAUNCHES == PER_PHASE) ? li + 1 : PER_PHASE;
        hipLaunchKernelGGL(mk_fwd, dim3(grid), dim3(NWAVES * 64), LDS_BYTES, stream, a);
        const hipError_t le = hipPeekAtLastError();
        if (le != hipSuccess) { fprintf(stderr, "kernel_launch: launch %d failed: %s\n", li, hipGetErrorName(le)); break; }
    }
}
```
